# Optimizing an MI355X kernel written in HIP

```python
import math
import jax
import jax.numpy as jnp
from jax import lax
import numpy as np

D_MODEL = 2048
BATCH = 4
SEQ = 2048
DEPTH = 4

N_MIXERS = 4
N_HEADS = 16
HEAD_DIM = 128
REL_BUCKETS = 32
REL_MAX_DIST = 128
BAND_BLOCK = 128
MOBA_BLOCK = 256
MOBA_TOPK = 3
MOBA_Q_CHUNK = 16
SWA_WINDOW = 128
SWA_KV_HEADS = 2
NSA_KV_HEADS = 4
NSA_CMP_LEN = 32
NSA_CMP_STRIDE = 16
NSA_CMP_HIDDEN = 256
NSA_SEL_BLOCK = 64
NSA_TOPN = 16
NSA_WINDOW = 512
NSA_Q_CHUNK = 32
MLA_Q_LORA = 512
MLA_KV_LORA = 512
MLA_NOPE_DIM = 128
MLA_ROPE_DIM = 64
MLA_V_DIM = 128
MLA_Q_BLOCK = 128
ROPE_BASE = 10000.0
D_FF = -(-8 * D_MODEL // 768) * 256
ALPHA = (2 * DEPTH) ** 0.25
BETA = (8 * DEPTH) ** -0.25
LN_EPS = 1e-5
RMS_EPS = 1e-6

kernel_name = 'hybrid_moba_swa_nsa_mla_deepnorm'


def layer_norm(x, g, b):
    xf = x.astype(jnp.float32)
    mu = jnp.mean(xf, axis=-1, keepdims=True)
    var = jnp.mean(jnp.square(xf - mu), axis=-1, keepdims=True)
    return ((xf - mu) * lax.rsqrt(var + LN_EPS) * g.astype(jnp.float32) + b.astype(jnp.float32)).astype(x.dtype)


def rms_norm(x, g):
    xf = x.astype(jnp.float32)
    y = xf * lax.rsqrt(jnp.mean(jnp.square(xf), axis=-1, keepdims=True) + RMS_EPS)
    return (y * g.astype(jnp.float32)).astype(x.dtype)


def t5_bucket(dist):
    n = jnp.maximum(dist, 0)
    max_exact = REL_BUCKETS // 2
    nf = jnp.maximum(n, max_exact).astype(jnp.float32)
    large = max_exact + (jnp.log(nf / max_exact) / math.log(REL_MAX_DIST / max_exact)
                         * (REL_BUCKETS - max_exact)).astype(jnp.int32)
    return jnp.where(n < max_exact, n, jnp.minimum(large, REL_BUCKETS - 1))


def masked_softmax(logits, mask):
    logits = jnp.where(mask, logits.astype(jnp.float32), -jnp.inf)
    m = jnp.max(logits, axis=-1, keepdims=True)
    m = jnp.where(jnp.isfinite(m), m, 0.0)
    p = jnp.exp(logits - m)
    return p / jnp.maximum(jnp.sum(p, axis=-1, keepdims=True), 1e-30)


def rope_tables(s):
    inv = ROPE_BASE ** (-jnp.arange(0, MLA_ROPE_DIM, 2, dtype=jnp.float32) / MLA_ROPE_DIM)
    ang = jnp.arange(s, dtype=jnp.float32)[:, None] * inv[None, :]
    return jnp.cos(ang), jnp.sin(ang)


def apply_rope(t, cos, sin):
    t1, t2 = jnp.split(t, 2, axis=-1)
    cos = cos.astype(t.dtype)
    sin = sin.astype(t.dtype)
    return jnp.concatenate([t1 * cos - t2 * sin, t1 * sin + t2 * cos], axis=-1)


def band_blocks(t, n_prev):
    b, hk, s, dh = t.shape
    nb = s // BAND_BLOCK
    tb = t.reshape(b, hk, nb, BAND_BLOCK, dh)
    tp = jnp.pad(tb, ((0, 0), (0, 0), (n_prev, 0), (0, 0), (0, 0)))
    return jnp.concatenate([tp[:, :, i:i + nb] for i in range(n_prev + 1)], axis=3)


def banded_gqa(q, k, v, window, bias_hg, sinks=None):
    b, hk, g, s, dh = q.shape
    nb = s // BAND_BLOCK
    n_prev = -(-(window - 1) // BAND_BLOCK)
    span = (n_prev + 1) * BAND_BLOCK
    kw = band_blocks(k, n_prev)
    vw = band_blocks(v, n_prev)
    qb = q.reshape(b, hk, g, nb, BAND_BLOCK, dh)
    logits = jnp.einsum('bkgnid,bknjd->bkgnij', qb, kw).astype(jnp.float32)
    i = jnp.arange(BAND_BLOCK)[:, None]
    j = jnp.arange(span)[None, :]
    dist = i + n_prev * BAND_BLOCK - j
    logits = logits + bias_hg[:, :, t5_bucket(dist)][None, :, :, None].astype(jnp.float32)
    qpos = (jnp.arange(nb) * BAND_BLOCK)[:, None, None] + i[None]
    mask = (dist >= 0) & (dist < window) & (qpos - dist >= 0)
    if sinks is None:
        p = masked_softmax(logits, mask)
    else:
        sink_col = jnp.broadcast_to(sinks.astype(jnp.float32)[None, :, :, None, None, None],
                                    logits.shape[:-1] + (1,))
        mask_s = jnp.pad(mask, ((0, 0), (0, 0), (0, 1)), constant_values=True)
        p = masked_softmax(jnp.concatenate([logits, sink_col], axis=-1), mask_s)[..., :span]
    out = jnp.einsum('bkgnij,bknjd->bkgnid', p.astype(v.dtype), vw)
    return out.reshape(b, hk, g, s, dh)


def moba_attention(q, k, v, bias_h):
    b, h, sp, dh = q.shape
    nb = sp // MOBA_BLOCK
    kb = k.reshape(b, h, nb, MOBA_BLOCK, dh)
    vb = v.reshape(b, h, nb, MOBA_BLOCK, dh)
    k_mean = jnp.mean(kb.astype(jnp.float32), axis=3)
    gate = jnp.einsum('bhsd,bhnd->bhsn', q.astype(jnp.float32), k_mean)
    q_blk = jnp.arange(sp) // MOBA_BLOCK
    fully_past = jnp.arange(nb)[None, :] < q_blk[:, None]
    gate = jnp.where(fully_past, gate, -jnp.inf)
    tk = max(1, min(MOBA_TOPK, nb - 1))
    _, sel = lax.top_k(gate, tk)
    nc = sp // MOBA_Q_CHUNK
    q_c = q.reshape(b, h, nc, MOBA_Q_CHUNK, dh).transpose(2, 0, 1, 3, 4)
    sel_c = sel.reshape(b, h, nc, MOBA_Q_CHUNK, tk).transpose(2, 0, 1, 3, 4)
    bi = jnp.arange(b)[:, None, None, None]
    hi = jnp.arange(h)[None, :, None, None]
    offs = jnp.arange(MOBA_BLOCK)
    n_sel = tk * MOBA_BLOCK

    def one_chunk(args):
        qc, selc, c = args
        qpos = c * MOBA_Q_CHUNK + jnp.arange(MOBA_Q_CHUNK)
        own = (c * MOBA_Q_CHUNK) // MOBA_BLOCK
        k_own = lax.dynamic_index_in_dim(kb, own, axis=2, keepdims=False)
        v_own = lax.dynamic_index_in_dim(vb, own, axis=2, keepdims=False)
        k_sel = kb[bi, hi, selc].reshape(b, h, MOBA_Q_CHUNK, n_sel, dh)
        v_sel = vb[bi, hi, selc].reshape(b, h, MOBA_Q_CHUNK, n_sel, dh)
        kpos_sel = (selc[..., None] * MOBA_BLOCK + offs).reshape(b, h, MOBA_Q_CHUNK, n_sel)
        kpos_own = own * MOBA_BLOCK + offs
        slot_ok = jnp.arange(tk)[None, :] < (qpos // MOBA_BLOCK)[:, None]
        mask_sel = jnp.repeat(slot_ok, MOBA_BLOCK, axis=-1)
        mask_own = kpos_own[None, :] <= qpos[:, None]
        l_sel = (jnp.einsum('bhqd,bhqjd->bhqj', qc, k_sel).astype(jnp.float32)
                 + bias_h[hi, t5_bucket(qpos[:, None] - kpos_sel)].astype(jnp.float32))
        l_own = (jnp.einsum('bhqd,bhjd->bhqj', qc, k_own).astype(jnp.float32)
                 + bias_h[:, t5_bucket(qpos[:, None] - kpos_own[None, :])].astype(jnp.float32))
        p = masked_softmax(jnp.concatenate([l_sel, l_own], axis=-1),
                           jnp.concatenate([mask_sel, mask_own], axis=-1)).astype(v.dtype)
        return (jnp.einsum('bhqj,bhqjd->bhqd', p[..., :n_sel], v_sel)
                + jnp.einsum('bhqj,bhjd->bhqd', p[..., n_sel:], v_own))

    out = lax.map(one_chunk, (q_c, sel_c, jnp.arange(nc)))
    return out.transpose(1, 2, 0, 3, 4).reshape(b, h, sp, dh)


def moba_mixer(x, w_qkv, w_o, rel_bias):
    b, s, _ = x.shape
    q, k, v = jnp.split(x @ w_qkv, 3, axis=-1)
    heads = lambda t: t.reshape(b, s, N_HEADS, HEAD_DIM).transpose(0, 2, 1, 3)
    q, k, v = heads(q) * HEAD_DIM ** -0.5, heads(k), heads(v)
    sp = -(-s // MOBA_BLOCK) * MOBA_BLOCK
    pad = ((0, 0), (0, 0), (0, sp - s), (0, 0))
    o = moba_attention(jnp.pad(q, pad), jnp.pad(k, pad), jnp.pad(v, pad), rel_bias.T)[:, :, :s]
    return o.transpose(0, 2, 1, 3).reshape(b, s, N_HEADS * HEAD_DIM) @ w_o


def swa_mixer(x, w_qkv, sinks, w_o, rel_bias):
    b, s, _ = x.shape
    g = N_HEADS // SWA_KV_HEADS
    q, k, v = jnp.split(x @ w_qkv, [N_HEADS * HEAD_DIM, (N_HEADS + SWA_KV_HEADS) * HEAD_DIM], axis=-1)
    q = q.reshape(b, s, SWA_KV_HEADS, g, HEAD_DIM).transpose(0, 2, 3, 1, 4) * HEAD_DIM ** -0.5
    k = k.reshape(b, s, SWA_KV_HEADS, HEAD_DIM).transpose(0, 2, 1, 3)
    v = v.reshape(b, s, SWA_KV_HEADS, HEAD_DIM).transpose(0, 2, 1, 3)
    bias_hg = rel_bias.T.reshape(SWA_KV_HEADS, g, REL_BUCKETS)
    o = banded_gqa(q, k, v, SWA_WINDOW, bias_hg, sinks.reshape(SWA_KV_HEADS, g))
    return o.transpose(0, 3, 1, 2, 4).reshape(b, s, N_HEADS * HEAD_DIM) @ w_o


def nsa_selected_attention(q, k, v, sel, sel_ok, bias_hg):
    b, hk, g, s, dh = q.shape
    n = sel.shape[-1]
    kb = k.reshape(b, hk, s // NSA_SEL_BLOCK, NSA_SEL_BLOCK, dh)
    vb = v.reshape(b, hk, s // NSA_SEL_BLOCK, NSA_SEL_BLOCK, dh)
    nc = s // NSA_Q_CHUNK
    q_c = q.reshape(b, hk, g, nc, NSA_Q_CHUNK, dh).transpose(3, 0, 1, 2, 4, 5)
    sel_c = sel.reshape(b, hk, nc, NSA_Q_CHUNK, n).transpose(2, 0, 1, 3, 4)
    ok_c = sel_ok.reshape(b, hk, nc, NSA_Q_CHUNK, n).transpose(2, 0, 1, 3, 4)
    bi = jnp.arange(b)[:, None, None, None]
    ki = jnp.arange(hk)[None, :, None, None]
    gi = jnp.arange(g)[None, None, :, None, None]
    offs = jnp.arange(NSA_SEL_BLOCK)

    def one_chunk(args):
        qc, selc, okc, c = args
        qpos = c * NSA_Q_CHUNK + jnp.arange(NSA_Q_CHUNK)
        ks = kb[bi, ki, selc].reshape(b, hk, NSA_Q_CHUNK, n * NSA_SEL_BLOCK, dh)
        vs = vb[bi, ki, selc].reshape(b, hk, NSA_Q_CHUNK, n * NSA_SEL_BLOCK, dh)
        kpos = (selc[..., None] * NSA_SEL_BLOCK + offs).reshape(b, hk, NSA_Q_CHUNK, n * NSA_SEL_BLOCK)
        dist = qpos[:, None] - kpos
        mask = (dist >= 0) & jnp.repeat(okc, NSA_SEL_BLOCK, axis=-1)
        bias = bias_hg[ki[..., None], gi, t5_bucket(dist)[:, :, None]].astype(jnp.float32)
        logits = jnp.einsum('bkgqd,bkqjd->bkgqj', qc, ks).astype(jnp.float32) + bias
        p = masked_softmax(logits, mask[:, :, None])
        return jnp.einsum('bkgqj,bkqjd->bkgqd', p.astype(vs.dtype), vs)

    out = lax.map(one_chunk, (q_c, sel_c, ok_c, jnp.arange(nc)))
    return out.transpose(1, 2, 3, 0, 4, 5).reshape(b, hk, g, s, dh)


def nsa_mixer(x, w_in, cmp_pos, cmp_w1, cmp_w2, w_o, rel_bias):
    b, s, _ = x.shape
    hk, dh = NSA_KV_HEADS, HEAD_DIM
    g = N_HEADS // hk
    kv_w = hk * dh
    splits = [int(c) for c in np.cumsum([N_HEADS * dh] + [kv_w] * 6)]
    parts = jnp.split(x @ w_in, splits, axis=-1)
    q = parts[0].reshape(b, s, hk, g, dh).transpose(0, 2, 3, 1, 4) * dh ** -0.5
    heads = lambda t: t.reshape(b, s, hk, dh).transpose(0, 2, 1, 3)
    k_cmp, v_cmp, k_slc, v_slc, k_win, v_win = [heads(t) for t in parts[1:7]]
    gates = jax.nn.sigmoid(parts[7].astype(jnp.float32)).reshape(b, s, hk, g, 3).transpose(0, 2, 3, 1, 4)
    bias_hg = rel_bias.T.reshape(hk, g, REL_BUCKETS)
    pos = jnp.arange(s)

    n_cmp = (s - NSA_CMP_LEN) // NSA_CMP_STRIDE + 1
    idx = jnp.arange(n_cmp)[:, None] * NSA_CMP_STRIDE + jnp.arange(NSA_CMP_LEN)[None, :]

    def compress(t, pe, w1, w2):
        blocks = t[:, :, idx] + pe
        hid = jax.nn.gelu(blocks.reshape(b, hk, n_cmp, NSA_CMP_LEN * dh) @ w1)
        return hid @ w2

    kc = compress(k_cmp, cmp_pos[0], cmp_w1[0], cmp_w2[0])
    vc = compress(v_cmp, cmp_pos[1], cmp_w1[1], cmp_w2[1])
    cmp_end = jnp.arange(n_cmp) * NSA_CMP_STRIDE + NSA_CMP_LEN - 1
    dist = pos[:, None] - cmp_end[None, :]
    logits = (jnp.einsum('bkgsd,bkcd->bkgsc', q, kc).astype(jnp.float32)
              + bias_hg[:, :, t5_bucket(dist)][None].astype(jnp.float32))
    p_cmp = masked_softmax(logits, dist >= 0)
    o_cmp = jnp.einsum('bkgsc,bkcd->bkgsd', p_cmp.astype(vc.dtype), vc)

    n_sel = s // NSA_SEL_BLOCK
    ci = jnp.arange(n_cmp)[:, None] * NSA_CMP_STRIDE
    sj = jnp.arange(n_sel)[None, :] * NSA_SEL_BLOCK
    overlap = ((ci < sj + NSA_SEL_BLOCK) & (ci + NSA_CMP_LEN > sj)).astype(jnp.float32)
    importance = jnp.einsum('bkgsc,cj->bksj', p_cmp, overlap)
    q_blk = (pos // NSA_SEL_BLOCK)[:, None]
    jj = jnp.arange(n_sel)[None, :]
    forced = (jj == 0) | (jj == q_blk) | (jj == q_blk - 1)
    importance = jnp.where(jj > q_blk, -jnp.inf, jnp.where(forced, jnp.inf, importance))
    top_val, sel = lax.top_k(importance, min(NSA_TOPN, n_sel))
    o_slc = nsa_selected_attention(q, k_slc, v_slc, sel, top_val > -jnp.inf, bias_hg)

    o_win = banded_gqa(q, k_win, v_win, NSA_WINDOW, bias_hg)

    o = (gates[..., 0:1] * o_cmp + gates[..., 1:2] * o_slc + gates[..., 2:3] * o_win).astype(x.dtype)
    return o.transpose(0, 3, 1, 2, 4).reshape(b, s, N_HEADS * dh) @ w_o


def mla_mixer(x, w_down, q_norm, kv_norm, w_uq, w_ukv, w_o):
    b, s, _ = x.shape
    h = N_HEADS
    c_q, c_kv, k_rope = jnp.split(x @ w_down, [MLA_Q_LORA, MLA_Q_LORA + MLA_KV_LORA], axis=-1)
    q = (rms_norm(c_q, q_norm) @ w_uq).reshape(b, s, h, MLA_NOPE_DIM + MLA_ROPE_DIM).transpose(0, 2, 1, 3)
    kv = (rms_norm(c_kv, kv_norm) @ w_ukv).reshape(b, s, h, MLA_NOPE_DIM + MLA_V_DIM).transpose(0, 2, 1, 3)
    cos, sin = rope_tables(s)
    scale = (MLA_NOPE_DIM + MLA_ROPE_DIM) ** -0.5
    q_nope = q[..., :MLA_NOPE_DIM] * scale
    q_rope = apply_rope(q[..., MLA_NOPE_DIM:], cos, sin) * scale
    k_nope, v = kv[..., :MLA_NOPE_DIM], kv[..., MLA_NOPE_DIM:]
    k_rope = apply_rope(k_rope, cos, sin)
    nqb = s // MLA_Q_BLOCK
    qn_c = q_nope.reshape(b, h, nqb, MLA_Q_BLOCK, MLA_NOPE_DIM).transpose(2, 0, 1, 3, 4)
    qr_c = q_rope.reshape(b, h, nqb, MLA_Q_BLOCK, MLA_ROPE_DIM).transpose(2, 0, 1, 3, 4)
    kpos = jnp.arange(s)

    def one_block(args):
        qn, qr, c = args
        qpos = c * MLA_Q_BLOCK + jnp.arange(MLA_Q_BLOCK)
        logits = (jnp.einsum('bhqd,bhkd->bhqk', qn, k_nope)
                  + jnp.einsum('bhqd,bkd->bhqk', qr, k_rope))
        p = masked_softmax(logits, kpos[None, :] <= qpos[:, None])
        return jnp.einsum('bhqk,bhkd->bhqd', p.astype(v.dtype), v)

    o = lax.map(one_block, (qn_c, qr_c, jnp.arange(nqb)))
    return o.transpose(1, 0, 3, 2, 4).reshape(b, s, h * MLA_V_DIM) @ w_o


def swiglu(x, w_gate, w_up, w_down):
    return (jax.nn.silu(x @ w_gate) * (x @ w_up)) @ w_down


def setup_inputs(seed: int = 0) -> dict:
    key = jax.random.key(seed)
    ks = iter(jax.random.split(key, 32))
    n_of = [(DEPTH - kind + N_MIXERS - 1) // N_MIXERS for kind in range(N_MIXERS)]
    na, nb_, nc, nd = n_of

    def nrm(shape, fan_in, gain=1.0):
        return jax.random.normal(next(ks), shape, jnp.float32) * (gain * fan_in ** -0.5)

    def noise(shape, scale):
        return jax.random.normal(next(ks), shape, jnp.float32) * scale

    hd = N_HEADS * HEAD_DIM
    nsa_in = hd + 6 * NSA_KV_HEADS * HEAD_DIM + 3 * N_HEADS
    return {
        'x': jax.random.normal(next(ks), (BATCH, SEQ, D_MODEL), jnp.float32),
        'rel_bias': noise((REL_BUCKETS, N_HEADS), 0.5),
        'moba_w_qkv': nrm((na, D_MODEL, 3 * hd), D_MODEL),
        'moba_w_o': nrm((na, hd, D_MODEL), hd, BETA),
        'swa_w_qkv': nrm((nb_, D_MODEL, (N_HEADS + 2 * SWA_KV_HEADS) * HEAD_DIM), D_MODEL),
        'swa_sinks': noise((nb_, N_HEADS), 1.0),
        'swa_w_o': nrm((nb_, hd, D_MODEL), hd, BETA),
        'nsa_w_in': nrm((nc, D_MODEL, nsa_in), D_MODEL),
        'nsa_cmp_pos': noise((nc, 2, NSA_CMP_LEN, HEAD_DIM), 0.1),
        'nsa_cmp_w1': nrm((nc, 2, NSA_CMP_LEN * HEAD_DIM, NSA_CMP_HIDDEN), NSA_CMP_LEN * HEAD_DIM),
        'nsa_cmp_w2': nrm((nc, 2, NSA_CMP_HIDDEN, HEAD_DIM), NSA_CMP_HIDDEN),
        'nsa_w_o': nrm((nc, hd, D_MODEL), hd, BETA),
        'mla_w_down': nrm((nd, D_MODEL, MLA_Q_LORA + MLA_KV_LORA + MLA_ROPE_DIM), D_MODEL),
        'mla_q_norm': 1.0 + noise((nd, MLA_Q_LORA), 0.02),
        'mla_kv_norm': 1.0 + noise((nd, MLA_KV_LORA), 0.02),
        'mla_w_uq': nrm((nd, MLA_Q_LORA, N_HEADS * (MLA_NOPE_DIM + MLA_ROPE_DIM)), MLA_Q_LORA),
        'mla_w_ukv': nrm((nd, MLA_KV_LORA, N_HEADS * (MLA_NOPE_DIM + MLA_V_DIM)), MLA_KV_LORA),
        'mla_w_o': nrm((nd, N_HEADS * MLA_V_DIM, D_MODEL), N_HEADS * MLA_V_DIM, BETA),
        'ln1_g': 1.0 + noise((DEPTH, D_MODEL), 0.02),
        'ln1_b': noise((DEPTH, D_MODEL), 0.02),
        'ffn_w_gate': nrm((DEPTH, D_MODEL, D_FF), D_MODEL),
        'ffn_w_up': nrm((DEPTH, D_MODEL, D_FF), D_MODEL),
        'ffn_w_down': nrm((DEPTH, D_FF, D_MODEL), D_FF, BETA),
        'ln2_g': 1.0 + noise((DEPTH, D_MODEL), 0.02),
        'ln2_b': noise((DEPTH, D_MODEL), 0.02),
    }


def reference(x, rel_bias, moba_w_qkv, moba_w_o, swa_w_qkv, swa_sinks, swa_w_o,
              nsa_w_in, nsa_cmp_pos, nsa_cmp_w1, nsa_cmp_w2, nsa_w_o,
              mla_w_down, mla_q_norm, mla_kv_norm, mla_w_uq, mla_w_ukv, mla_w_o,
              ln1_g, ln1_b, ffn_w_gate, ffn_w_up, ffn_w_down, ln2_g, ln2_b):
    for i in range(DEPTH):
        kind, j = i % N_MIXERS, i // N_MIXERS
        if kind == 0:
            h = moba_mixer(x, moba_w_qkv[j], moba_w_o[j], rel_bias)
        elif kind == 1:
            h = swa_mixer(x, swa_w_qkv[j], swa_sinks[j], swa_w_o[j], rel_bias)
        elif kind == 2:
            h = nsa_mixer(x, nsa_w_in[j], nsa_cmp_pos[j], nsa_cmp_w1[j], nsa_cmp_w2[j], nsa_w_o[j], rel_bias)
        else:
            h = mla_mixer(x, mla_w_down[j], mla_q_norm[j], mla_kv_norm[j], mla_w_uq[j], mla_w_ukv[j], mla_w_o[j])
        x = layer_norm(ALPHA * x + h, ln1_g[i], ln1_b[i])
        x = layer_norm(ALPHA * x + swiglu(x, ffn_w_gate[i], ffn_w_up[i], ffn_w_down[i]), ln2_g[i], ln2_b[i])
    return x
```

```cpp
#include <hip/hip_runtime.h>
#include <hip/hip_cooperative_groups.h>
#include <cstdio>
namespace cg = cooperative_groups;
namespace pg8 {
#define PG8_LAS __attribute__((address_space(3)))
typedef unsigned short bf16_t;
typedef short bf16x8 __attribute__((ext_vector_type(8)));
typedef float f32x4 __attribute__((ext_vector_type(4)));
typedef unsigned u32x4 __attribute__((ext_vector_type(4)));
constexpr int BM = 256, BK = 64, HALF = 128, HTB = HALF * BK * 2  , STAGE_BYTES = 8 * HTB, NXCD = 8, WGM = 8;

__host__ __device__ __forceinline__ int lds_byte(int r, int c) { const int st = (r >> 4) * 2 + (c >> 5), rr = r & 15, cc = c & 31, ob = rr * 64 + cc * 2; return st * 1024 + (ob ^ (((ob >> 9) & 1) << 5)); }
__host__ __device__ __forceinline__ void stage_rc(int b, int& R, int& C) { const int st = b / 1024, sb = b % 1024, swz = sb ^ (((sb >> 9) & 1) << 5); R = (st >> 1) * 16 + swz / 64; C = (st & 1) * 32 + (swz % 64) / 2; }
__host__ __device__ __forceinline__ int perm32(int rho) { const int n = rho >> 4, i = rho & 15; return 8 * (i >> 2) + 4 * n + (i & 3); }

struct Unit { int pm, pn; };
struct Gemm { const bf16_t* A; const bf16_t* Bt; int M, N, K; };

struct StaticOrder {
    int nM, nN, nwg, G, c;
    __host__ __device__ void init(int M, int N, int G_, int c_) { nM = M / BM; nN = N / BM; nwg = nM * nN; G = G_; c = c_; }
    __host__ __device__ bool next(int i, Unit& u) const {
        const long L = (long)i * G + c; if (L >= nwg) return false;
        int wgid = (int)L; { const int q = nwg / NXCD, r = nwg % NXCD, xcd = wgid % NXCD, off = wgid / NXCD; wgid = (xcd < r ? xcd * (q + 1) : r * (q + 1) + (xcd - r) * q) + off; }
        const int nig = WGM * nN, gid = wgid / nig, fm = gid * WGM, gsz = (nM - fm) < WGM ? (nM - fm) : WGM;
        u.pm = fm + ((wgid % nig) % gsz); u.pn = (wgid % nig) / gsz; return true;
    }
    __device__ __forceinline__ void a_ready(const Unit&) const {}
    __device__ __forceinline__ void done(const Unit&) const {}
};
__device__ __forceinline__ unsigned cvt_pk_bf16(float lo, float hi) { unsigned r; asm volatile("v_cvt_pk_bf16_f32 %0, %1, %2" : "=v"(r) : "v"(lo), "v"(hi)); return r; }
typedef float f32x2 __attribute__((ext_vector_type(2)));
struct EpiF32 {
    static constexpr bool PERM = false, AFTER_DRAIN = false;
    float* C; int ldc;
    __device__ __forceinline__ void operator()(const f32x4 (&acc)[2][2][4][2], const Unit& u, int wr, int wc, int fr, int fq) const {
        const int row0 = u.pm * BM + wr * 64 + fr, col0 = u.pn * BM + wc * 32 + 4 * fq;
#pragma unroll
        for (int ai = 0; ai < 2; ++ai)
#pragma unroll
            for (int m = 0; m < 4; ++m) { float* rowp = C + (size_t)(row0 + ai * HALF + m * 16) * ldc + col0;
#pragma unroll
                for (int bj = 0; bj < 2; ++bj)
#pragma unroll
                    for (int n = 0; n < 2; ++n) *(f32x4*)(rowp + bj * HALF + n * 16) = acc[ai][bj][m][n]; }
    }
};
struct EpiRes {
    static constexpr bool PERM = false, AFTER_DRAIN = false;
    float* C; const float* base; int ldc; float alpha;
    __device__ __forceinline__ void operator()(const f32x4 (&acc)[2][2][4][2], const Unit& u, int wr, int wc, int fr, int fq) const {
        const int row0 = u.pm * BM + wr * 64 + fr, col0 = u.pn * BM + wc * 32 + 4 * fq;
#pragma unroll
        for (int ai = 0; ai < 2; ++ai)
#pragma unroll
            for (int m = 0; m < 4; ++m) { const size_t off = (size_t)(row0 + ai * HALF + m * 16) * ldc + col0;
#pragma unroll
                for (int bj = 0; bj < 2; ++bj)
#pragma unroll
                    for (int n = 0; n < 2; ++n) { const f32x4 b = *(const f32x4*)(base + off + bj * HALF + n * 16);
                        *(f32x4*)(C + off + bj * HALF + n * 16) = b * alpha + acc[ai][bj][m][n]; } }
    }
};
struct EpiBf16 {
    static constexpr bool PERM = true, AFTER_DRAIN = false;
    bf16_t* O; int ldc;
    __device__ __forceinline__ void operator()(const f32x4 (&acc)[2][2][4][2], const Unit& u, int wr, int wc, int fr, int fq) const {
        const int row0 = u.pm * BM + wr * 64 + fr; const int col0 = u.pn * BM + wc * 32 + 8 * fq;
#pragma unroll
        for (int ai = 0; ai < 2; ++ai)
#pragma unroll
            for (int m = 0; m < 4; ++m) { bf16_t* rowp = O + (size_t)(row0 + ai * HALF + m * 16) * ldc + col0;
#pragma unroll
                for (int bj = 0; bj < 2; ++bj) { const f32x4 v0 = acc[ai][bj][m][0], v1 = acc[ai][bj][m][1];
                    u32x4 w; w.x = cvt_pk_bf16(v0[0], v0[1]); w.y = cvt_pk_bf16(v0[2], v0[3]); w.z = cvt_pk_bf16(v1[0], v1[1]); w.w = cvt_pk_bf16(v1[2], v1[3]);
                    *(u32x4*)(rowp + bj * HALF) = w; } }
    }
};
__device__ __forceinline__ float silu_f(float x) { return x / (1.0f + __expf(-x)); }
struct EpiSwiGLU {
    static constexpr bool PERM = true, AFTER_DRAIN = false;
    bf16_t* H; int ldc;
    __device__ __forceinline__ void operator()(const f32x4 (&acc)[2][2][4][2], const Unit& u, int wr, int wc, int fr, int fq) const {
        const int row0 = u.pm * BM + wr * 64 + fr; const int col0 = u.pn * HALF + wc * 32 + 8 * fq;
#pragma unroll
        for (int ai = 0; ai < 2; ++ai)
#pragma unroll
            for (int m = 0; m < 4; ++m) { bf16_t* rowp = H + (size_t)(row0 + ai * HALF + m * 16) * ldc + col0;
                f32x4 h0, h1;
#pragma unroll
                for (int j = 0; j < 4; ++j) { h0[j] = silu_f(acc[ai][0][m][0][j]) * acc[ai][1][m][0][j]; h1[j] = silu_f(acc[ai][0][m][1][j]) * acc[ai][1][m][1][j]; }
                u32x4 w; w.x = cvt_pk_bf16(h0[0], h0[1]); w.y = cvt_pk_bf16(h0[2], h0[3]); w.z = cvt_pk_bf16(h1[0], h1[1]); w.w = cvt_pk_bf16(h1[2], h1[3]);
                *(u32x4*)rowp = w; }
    }
};

template <class Epi, class Sched, bool STAMP = false>
__device__ __forceinline__ void gemm_phase(PG8_LAS unsigned char* lds, const Gemm g, const Sched& S, const Epi& E, unsigned long long* stamps) {
    int tid_l = threadIdx.x; asm volatile("" : "+v"(tid_l)); const int tid = tid_l, wid = __builtin_amdgcn_readfirstlane(tid >> 6), lane = tid & 63, wr = wid >> 2, wc = wid & 3, fr = lane & 15, fq = lane >> 4;
    const int K = g.K, nt = K / BK;
    int ts_lo = 0, ts_hi = 0, nts = 0; const unsigned long long rt_entry = STAMP ? (unsigned long long)wall_clock64() : 0ull;
#define PG8_STAMP() do { if (STAMP && wid == 0 && nts < 64) { const unsigned long long _c = (unsigned long long)clock64(); \
        ts_lo = (lane == nts) ? (int)(unsigned)_c : ts_lo; ts_hi = (lane == nts) ? (int)(unsigned)(_c >> 32) : ts_hi; ++nts; } } while (0)
    PG8_STAMP();
    unsigned voffA[2], voffB[2];
#pragma unroll
    for (int i = 0; i < 2; ++i) { int R, C; stage_rc(tid * 16 + i * 8192, R, C); const int Rb = Epi::PERM ? ((R & ~31) + perm32(R & 31)) : R;
        voffA[i] = (unsigned)(R * K + C) * 2u; voffB[i] = (unsigned)(Rb * K + C) * 2u; }
    const size_t kstep = (size_t)(BK * 2);
    const size_t hstep = (size_t)HALF * K * 2;
    const size_t tstep = 2 * hstep;
    const unsigned ldsw = (unsigned)wid * 1024u;
    const int aoff = lds_byte(wr * 64 + fr, fq * 8), boff = lds_byte(wc * 32 + fr, fq * 8);
#define PG8_SA(b, h) (((b) * 2 + (h)) * HTB)
#define PG8_SB(b, h) ((4 + (b) * 2 + (h)) * HTB)
#define PG8_STAGE(bufoff, gbase, voff) do { _Pragma("unroll") for (int _i = 0; _i < 2; ++_i) \
        __builtin_amdgcn_global_load_lds((const unsigned*)((const char*)(gbase) + (voff)[_i]), (PG8_LAS unsigned*)(lds + (bufoff) + ldsw + _i * 8192), 16, 0, 0); } while (0)
#define PG8_LDA(dst, b, h) do { _Pragma("unroll") for (int m = 0; m < 4; ++m) _Pragma("unroll") for (int k = 0; k < 2; ++k) dst[m][k] = *(const PG8_LAS bf16x8*)(lds + PG8_SA(b, h) + aoff + m * 2048 + k * 1024); } while (0)
#define PG8_LDB(dst, b, h) do { _Pragma("unroll") for (int n = 0; n < 2; ++n) _Pragma("unroll") for (int k = 0; k < 2; ++k) dst[n][k] = *(const PG8_LAS bf16x8*)(lds + PG8_SB(b, h) + boff + n * 2048 + k * 1024); } while (0)
#define PG8_MMA(ai, bj, At, Bt) do { __builtin_amdgcn_s_setprio(1); _Pragma("unroll") for (int m = 0; m < 4; ++m) _Pragma("unroll") for (int n = 0; n < 2; ++n) _Pragma("unroll") for (int k = 0; k < 2; ++k) \
        acc[ai][bj][m][n] = __builtin_amdgcn_mfma_f32_16x16x32_bf16(Bt[n][k], At[m][k], acc[ai][bj][m][n], 0, 0, 0); __builtin_amdgcn_s_setprio(0); } while (0)
#define PG8_WAIT_V(n) asm volatile("s_waitcnt vmcnt(" #n ")" ::: "memory")
#define PG8_WAIT_L(n) asm volatile("s_waitcnt lgkmcnt(" #n ")" ::: "memory")
#define PG8_BAR __builtin_amdgcn_s_barrier()
#define PG8_SCHED __builtin_amdgcn_sched_barrier(0)
    Unit cur, nxt; int ui = 0;
    if (!S.next(0, cur)) return;
    f32x4 acc[2][2][4][2];
#pragma unroll
    for (int a = 0; a < 2; ++a)
#pragma unroll
        for (int b = 0; b < 2; ++b)
#pragma unroll
            for (int m = 0; m < 4; ++m)
#pragma unroll
                for (int n = 0; n < 2; ++n) acc[a][b][m][n] = (f32x4){0.f, 0.f, 0.f, 0.f};
    bf16x8 At[4][2], B0[2][2], B1[2][2];
    const char* cA = (const char*)g.A + (size_t)cur.pm * tstep; const char* cB = (const char*)g.Bt + (size_t)cur.pn * tstep;
    S.a_ready(cur);
    PG8_STAGE(PG8_SB(0, 0), cB, voffB); PG8_STAGE(PG8_SA(0, 0), cA, voffA); PG8_STAGE(PG8_SB(0, 1), cB + hstep, voffB); PG8_STAGE(PG8_SA(0, 1), cA + hstep, voffA);
    if (wr == 1) PG8_BAR;
    PG8_WAIT_V(4); PG8_BAR;
    PG8_STAGE(PG8_SB(1, 0), cB + kstep, voffB); PG8_STAGE(PG8_SA(1, 0), cA + kstep, voffA); PG8_STAGE(PG8_SB(1, 1), cB + hstep + kstep, voffB);
    PG8_WAIT_V(6); PG8_BAR;
    PG8_STAMP();
    for (;;) {
        const bool has_next = S.next(ui + 1, nxt);
        const char* nA = has_next ? (const char*)g.A + (size_t)nxt.pm * tstep : cA; const char* nB = has_next ? (const char*)g.Bt + (size_t)nxt.pn * tstep : cB;
        for (int t = 0; t < nt; t += 2) {
            const bool last = (t == nt - 2);
            const char* a1 = cA + (size_t)(t + 1) * kstep;
            const char* a2 = last ? nA : cA + (size_t)(t + 2) * kstep; const char* b2 = last ? nB : cB + (size_t)(t + 2) * kstep;
            const char* a3 = a2 + kstep; const char* b3 = b2 + kstep;
            if (last && has_next) S.a_ready(nxt);
            PG8_LDB(B0, 0, 0); PG8_SCHED; PG8_LDA(At, 0, 0); PG8_STAGE(PG8_SA(1, 1), a1 + hstep, voffA);
            PG8_WAIT_L(8); PG8_BAR; PG8_WAIT_L(0); PG8_MMA(0, 0, At, B0); PG8_BAR; PG8_SCHED;
            PG8_LDB(B1, 0, 1); PG8_STAGE(PG8_SB(0, 0), b2, voffB);
            PG8_BAR; PG8_WAIT_L(0); PG8_MMA(0, 1, At, B1); PG8_BAR;
            PG8_LDA(At, 0, 1); PG8_STAGE(PG8_SA(0, 0), a2, voffA);
            PG8_BAR; PG8_WAIT_L(0); PG8_MMA(1, 0, At, B0); PG8_BAR; PG8_SCHED;
            PG8_STAGE(PG8_SB(0, 1), b2 + hstep, voffB);
            PG8_WAIT_V(6); PG8_BAR; PG8_MMA(1, 1, At, B1); PG8_BAR;
            PG8_LDB(B0, 1, 0); PG8_SCHED; PG8_LDA(At, 1, 0); PG8_STAGE(PG8_SA(0, 1), a2 + hstep, voffA);
            PG8_WAIT_L(8); PG8_BAR; PG8_WAIT_L(0); PG8_MMA(0, 0, At, B0); PG8_BAR; PG8_SCHED;
            PG8_LDB(B1, 1, 1); PG8_STAGE(PG8_SB(1, 0), b3, voffB);
            PG8_BAR; PG8_WAIT_L(0); PG8_MMA(0, 1, At, B1); PG8_BAR;
            PG8_LDA(At, 1, 1); PG8_STAGE(PG8_SA(1, 0), a3, voffA);
            PG8_BAR; PG8_WAIT_L(0); PG8_MMA(1, 0, At, B0); PG8_BAR; PG8_SCHED;
            PG8_STAGE(PG8_SB(1, 1), b3 + hstep, voffB);
            PG8_WAIT_V(6); PG8_BAR; PG8_MMA(1, 1, At, B1); PG8_BAR;
        }
        PG8_STAMP();
        if constexpr (!Epi::AFTER_DRAIN) { E(acc, cur, wr, wc, fr, fq); S.done(cur); }
        PG8_STAMP();
        if (!has_next) break;
#pragma unroll
        for (int a = 0; a < 2; ++a)
#pragma unroll
            for (int b = 0; b < 2; ++b)
#pragma unroll
                for (int m = 0; m < 4; ++m)
#pragma unroll
                    for (int n = 0; n < 2; ++n) acc[a][b][m][n] = (f32x4){0.f, 0.f, 0.f, 0.f};
        cur = nxt; cA = nA; cB = nB; ++ui;
    }
    PG8_WAIT_V(0);
    if (wr == 0) PG8_BAR;
    PG8_BAR;
    if constexpr (Epi::AFTER_DRAIN) { E.fused(acc, cur, wr, wc, fr, fq, lds, wid, lane); S.done(cur); }
    PG8_STAMP();
    if (STAMP && wid == 0) { stamps[lane] = lane < nts ? (((unsigned long long)(unsigned)ts_hi << 32) | (unsigned)ts_lo) : 0ull;
        if (lane == 62) stamps[62] = rt_entry; if (lane == 63) stamps[63] = (unsigned long long)wall_clock64(); }
#undef PG8_STAMP
#undef PG8_SA
#undef PG8_SB
#undef PG8_STAGE
#undef PG8_LDA
#undef PG8_LDB
#undef PG8_MMA
#undef PG8_WAIT_V
#undef PG8_WAIT_L
#undef PG8_BAR
#undef PG8_SCHED
}
}

#define LAS __attribute__((address_space(3)))
typedef unsigned short bf16_t;
typedef short s16x8 __attribute__((ext_vector_type(8)));
typedef short s16x4 __attribute__((ext_vector_type(4)));
typedef float f32x4 __attribute__((ext_vector_type(4)));
typedef unsigned u32x4 __attribute__((ext_vector_type(4)));
typedef unsigned u32x2 __attribute__((ext_vector_type(2)));

constexpr int DM = 2048, NB = 4, SEQ = 2048, NTOK = NB * SEQ, DFF = 5632, NHEAD = 16, HD = 128;
constexpr int NSA_LD = 5376, MOBA_LD = 6144, SWA_LD = 2560, MLA_DN_LD = 1280, MLA_Q_LD = 3072, MLA_KV_LD = 4096;
constexpr float ALPHA_F = 1.681792830507429f;
constexpr int LDS_BYTES = 131072;
constexpr int NJOBS = 26;

struct CvtJob { const float* src; bf16_t* dst; int K, N, Npad, blk, stride, off, tile0, pad; };
struct Params {
    const float* x; const float* rel_bias; const float* swa_sinks; const float* cmp_pos; const float* cmp_w1;
    const float* q_norm; const float* kv_norm;
    const float* ln1_g; const float* ln1_b; const float* ln2_g; const float* ln2_b;
    float* out;
    const bf16_t* w_moba_qkv; const bf16_t* w_moba_o; const bf16_t* w_swa_qkv; const bf16_t* w_swa_o;
    const bf16_t* w_nsa_in; const bf16_t* w_nsa_o; const bf16_t* w_cmp1; const bf16_t* w_cmp2;
    const bf16_t* w_mla_down; const bf16_t* w_mla_uq; const bf16_t* w_mla_ukv; const bf16_t* w_mla_o;
    const bf16_t* w_gu; const bf16_t* w_dn;
    bf16_t* xb; float* xf; float* y; bf16_t* proj; bf16_t* hid; bf16_t* att;
    float* kmean; float* pe_bias; float* rope; bf16_t* cmp_hid; bf16_t* kcvc; float* cdown; bf16_t* cqn; bf16_t* ckvn; bf16_t* krope;
    CvtJob jobs[NJOBS];
    int njobs, total_tiles;
};

typedef const __attribute__((address_space(4))) Params* KP;
__device__ __forceinline__ const Params& PK(KP kp) { asm volatile("" : "+s"(kp)); return *(const Params*)kp; }
__device__ __forceinline__ int ltid() { int t = threadIdx.x; asm volatile("" : "+v"(t)); return t; }
__device__ __forceinline__ float bf2f(bf16_t b) { return __uint_as_float(((unsigned)b) << 16); }
__device__ __forceinline__ bf16_t f2bf(float f) { unsigned u = __float_as_uint(f); u += 0x7FFFu + ((u >> 16) & 1u); return (bf16_t)(u >> 16); }
__device__ __forceinline__ unsigned pk2(float lo, float hi) { return pg8::cvt_pk_bf16(lo, hi); }

__device__ __forceinline__ void phase0(const Params& p, LAS unsigned char* lds) {
    const int tid = ltid();
    LAS bf16_t* T = (LAS bf16_t*)lds;
    for (int t = blockIdx.x; t < p.total_tiles; t += gridDim.x) {
        int ji = 0;
#pragma unroll 1
        for (int j = 1; j < p.njobs; ++j) if (t >= p.jobs[j].tile0) ji = j;
        const CvtJob jb = p.jobs[ji];
        const int lt = t - jb.tile0, nkt = jb.K / 64, tn = lt / nkt, tk = lt % nkt, n0 = tn * 64, k0 = tk * 64;
#pragma unroll
        for (int pass = 0; pass < 2; ++pass) {
            const int k = (tid >> 4) + pass * 32, n4 = (tid & 15) * 4;
            f32x4 v = (f32x4){0.f, 0.f, 0.f, 0.f};
            if (n0 + n4 < jb.N) v = *(const f32x4*)(jb.src + (size_t)(k0 + k) * jb.N + n0 + n4);
#pragma unroll
            for (int i = 0; i < 4; ++i) T[(n4 + i) * 72 + k] = f2bf(v[i]);
        }
        __syncthreads();
        {
            const int n = tid >> 3, k8 = (tid & 7) * 8, gn = n0 + n;
            const int row = (gn / jb.blk) * jb.stride + jb.off + (gn % jb.blk);
            const u32x4 w = *(const LAS u32x4*)(T + n * 72 + k8);
            *(u32x4*)(jb.dst + (size_t)row * jb.K + k0 + k8) = w;
        }
        __syncthreads();
    }
    {
        const size_t n8 = (size_t)NTOK * DM / 8;
        for (size_t i = (size_t)blockIdx.x * 512 + tid; i < n8; i += (size_t)gridDim.x * 512) {
            const f32x4 a = *(const f32x4*)(p.x + i * 8), b = *(const f32x4*)(p.x + i * 8 + 4);
            u32x4 w; w.x = pk2(a[0], a[1]); w.y = pk2(a[2], a[3]); w.z = pk2(b[0], b[1]); w.w = pk2(b[2], b[3]);
            *(u32x4*)(p.xb + i * 8) = w;
        }
    }
    for (int i = blockIdx.x * 512 + tid; i < SEQ * 32; i += gridDim.x * 512) {
        const int s = i >> 5, f = i & 31;
        const float inv = exp2f(-(float)(2 * f) * (13.287712379549449f / 64.0f));
        const float ang = (float)s * inv;
        const double a = (double)ang, k = rint(a * 0.15915494309189535);
        const float r = (float)(a - k * 6.283185307179586);
        p.rope[s * 64 + f] = __cosf(r); p.rope[s * 64 + 32 + f] = __sinf(r);
    }
    if (blockIdx.x < 2) {
        const int kv = blockIdx.x, n = tid & 255, half = tid >> 8;
        const float* pe = p.cmp_pos + kv * 4096; const float* w1 = p.cmp_w1 + (size_t)kv * 4096 * 256;
        float s = 0.f;
        for (int k = half * 2048; k < half * 2048 + 2048; ++k) s += pe[k] * w1[(size_t)k * 256 + n];
        LAS float* R = (LAS float*)lds;
        __syncthreads();
        R[tid] = s;
        __syncthreads();
        if (tid < 256) p.pe_bias[kv * 256 + tid] = R[tid] + R[tid + 256];
        __syncthreads();
    }
}

__device__ __forceinline__ void ln_phase(const float* y, const float* g, const float* b, float* xf, bf16_t* xb) {
    const int tid = ltid(), lane = tid & 63, wave = tid >> 6;
    for (int row = blockIdx.x * 8 + wave; row < NTOK; row += gridDim.x * 8) {
        const float* yr = y + (size_t)row * DM;
        f32x4 v[8]; float s = 0.f;
#pragma unroll
        for (int i = 0; i < 8; ++i) { v[i] = *(const f32x4*)(yr + i * 256 + lane * 4); s += (v[i][0] + v[i][1]) + (v[i][2] + v[i][3]); }
#pragma unroll
        for (int o = 32; o > 0; o >>= 1) s += __shfl_xor(s, o);
        const float mean = s * (1.0f / DM); float q = 0.f;
#pragma unroll
        for (int i = 0; i < 8; ++i) { const f32x4 d = v[i] - mean; q += (d[0] * d[0] + d[1] * d[1]) + (d[2] * d[2] + d[3] * d[3]); }
#pragma unroll
        for (int o = 32; o > 0; o >>= 1) q += __shfl_xor(q, o);
        const float rstd = rsqrtf(q * (1.0f / DM) + 1e-5f);
#pragma unroll
        for (int i = 0; i < 8; ++i) {
            const int c = i * 256 + lane * 4;
            const f32x4 gg = *(const f32x4*)(g + c), bb = *(const f32x4*)(b + c);
            const f32x4 o = (v[i] - mean) * rstd * gg + bb;
            *(f32x4*)(xf + (size_t)row * DM + c) = o;
            if (xb) { u32x2 w; w.x = pk2(o[0], o[1]); w.y = pk2(o[2], o[3]); *(u32x2*)(xb + (size_t)row * DM + c) = w; }
        }
    }
}

constexpr int A_KB0 = 0, A_KBSZ = 25600, A_VB0 = 51200, A_VBSZ = 18432, A_LUT = 88064, A_LUTS = 132, A_RMASK = 92288, A_UMASK = 93312, A_IMP = 93440, A_IMPF = 109824;
constexpr int VSTR = 288;
constexpr float NEG_BIG = -1e30f;

__device__ __forceinline__ s16x4 vtr(const LAS unsigned char* pp) {
    typedef short v4i16_t __attribute__((ext_vector_type(4)));
    return __builtin_bit_cast(s16x4, __builtin_amdgcn_ds_read_tr16_b64_v4i16((LAS v4i16_t*)pp));
}

__device__ __forceinline__ int t5_bucket_dev(int n) {
    if (n < 16) return n;
    const float nf = (float)n;
    int large = 16 + (int)(logf(nf / 16.0f) / 2.0794415416798357f * 16.0f);
    return large < 31 ? large : 31;
}
__device__ __forceinline__ void build_lut(LAS unsigned char* lds, const float* rel_bias, int h0, int G) {
    LAS float* L = (LAS float*)(lds + A_LUT);
    for (int i = ltid(); i < G * 129; i += 512) { const int g = i / 129, d = i % 129; L[g * A_LUTS + d] = rel_bias[t5_bucket_dev(d) * NHEAD + h0 + g]; }
}

template <int DQK>
struct KVSrc { const bf16_t* K; size_t ldk; const bf16_t* K2; size_t ldk2; const bf16_t* V; size_t ldv; int nk; };

template <int DQK>
__device__ __forceinline__ void kv_gload(const KVSrc<DQK>& s, int jt, u32x4 (&kr)[DQK / 64], u32x4 (&vr)[2]) {
    constexpr int CPR = DQK / 8;
    const int tid = ltid();
#pragma unroll
    for (int i = 0; i < DQK / 64; ++i) {
        const int c = tid + i * 512, row = c / CPR, ch = c % CPR, j = jt * 64 + row;
        u32x4 v = (u32x4){0u, 0u, 0u, 0u};
        if (j < s.nk) { if (DQK == 128 || ch < 16) v = *(const u32x4*)(s.K + (size_t)j * s.ldk + ch * 8); else v = *(const u32x4*)(s.K2 + (size_t)j * s.ldk2 + (ch - 16) * 8); }
        kr[i] = v;
    }
#pragma unroll
    for (int i = 0; i < 2; ++i) {
        const int c = tid + i * 512, row = c >> 4, ch = c & 15, j = jt * 64 + row;
        u32x4 v = (u32x4){0u, 0u, 0u, 0u};
        if (j < s.nk) v = *(const u32x4*)(s.V + (size_t)j * s.ldv + ch * 8);
        vr[i] = v;
    }
}
template <int DQK>
__device__ __forceinline__ void kv_lstore(LAS unsigned char* lds, int buf, const u32x4 (&kr)[DQK / 64], const u32x4 (&vr)[2]) {
    constexpr int CPR = DQK / 8, KSTR = DQK * 2 + 16;
    const int tid = ltid();
#pragma unroll
    for (int i = 0; i < DQK / 64; ++i) { const int c = tid + i * 512, row = c / CPR, ch = c % CPR; *(LAS u32x4*)(lds + A_KB0 + buf * A_KBSZ + row * KSTR + ch * 16) = kr[i]; }
#pragma unroll
    for (int i = 0; i < 2; ++i) { const int c = tid + i * 512, row = c >> 4, ch = c & 15; *(LAS u32x4*)(lds + A_VB0 + buf * A_VBSZ + row * VSTR + ch * 16) = vr[i]; }
}

struct MaskCfg { int KS, KO, W, bsh, nk; float scale; };

template <int DQK, int QT, bool BIAS>
__device__ __forceinline__ void qk_tile(LAS unsigned char* lds, int buf, int jt, const s16x8 (&Qf)[QT][DQK / 32], f32x4 (&S)[4][QT],
                                        const MaskCfg& mc, const int (&qpos)[QT], const unsigned (&rmask)[QT], const int (&gl)[QT]) {
    constexpr int KSTR = DQK * 2 + 16;
    const int lane = ltid() & 63, fr = lane & 15, g4 = lane >> 4;
    const LAS unsigned char* kb = lds + A_KB0 + buf * A_KBSZ + fr * KSTR + g4 * 16;
#pragma unroll
    for (int kt = 0; kt < 4; ++kt) {
#pragma unroll
        for (int qt = 0; qt < QT; ++qt) S[kt][qt] = (f32x4){0.f, 0.f, 0.f, 0.f};
#pragma unroll
        for (int ks = 0; ks < DQK / 32; ++ks) {
            const s16x8 kf = *(const LAS s16x8*)(kb + kt * 16 * KSTR + ks * 64);
#pragma unroll
            for (int qt = 0; qt < QT; ++qt) S[kt][qt] = __builtin_amdgcn_mfma_f32_16x16x32_bf16(kf, Qf[qt][ks], S[kt][qt], 0, 0, 0);
        }
    }
    const LAS float* L = (const LAS float*)(lds + A_LUT);
#pragma unroll
    for (int qt = 0; qt < QT; ++qt)
#pragma unroll
        for (int kt = 0; kt < 4; ++kt)
#pragma unroll
            for (int i = 0; i < 4; ++i) {
                const int j = jt * 64 + kt * 16 + g4 * 4 + i;
                const int dist = qpos[qt] - (j * mc.KS + mc.KO);
                const bool ok = (dist >= 0) && (dist < mc.W) && (j < mc.nk) && ((rmask[qt] >> (j >> mc.bsh)) & 1u);
                float s = S[kt][qt][i] * mc.scale;
                if (BIAS) { int dd = dist < 0 ? 0 : (dist > 128 ? 128 : dist); s += L[gl[qt] * A_LUTS + dd]; }
                S[kt][qt][i] = ok ? s : NEG_BIG;
            }
}

template <int DQK, int QT, bool BIAS>
__device__ __forceinline__ void attn_pass(LAS unsigned char* lds, const KVSrc<DQK>& src, unsigned long long act, const MaskCfg& mc,
                                          const s16x8 (&Qf)[QT][DQK / 32], f32x4 (&O)[8][QT], float (&m)[QT], float (&l)[QT],
                                          const int (&qpos)[QT], const unsigned (&rmask)[QT], const int (&gl)[QT]) {
    const int lane = ltid() & 63, g4 = lane >> 4, q4 = (lane & 15) >> 2, p4 = lane & 3;
    if (act == 0ull) return;
    u32x4 kr[DQK / 64], vr[2];
    int jt = __builtin_ctzll(act); act &= act - 1ull;
    kv_gload<DQK>(src, jt, kr, vr);
    __syncthreads();
    kv_lstore<DQK>(lds, 0, kr, vr);
    __syncthreads();
    int buf = 0;
    for (;;) {
        const bool has_next = (act != 0ull);
        int jn = 0;
        if (has_next) { jn = __builtin_ctzll(act); act &= act - 1ull; kv_gload<DQK>(src, jn, kr, vr); }
        f32x4 S[4][QT];
        qk_tile<DQK, QT, BIAS>(lds, buf, jt, Qf, S, mc, qpos, rmask, gl);
        s16x8 Pf[2][QT];
#pragma unroll
        for (int qt = 0; qt < QT; ++qt) {
            float mx = NEG_BIG;
#pragma unroll
            for (int kt = 0; kt < 4; ++kt)
#pragma unroll
                for (int i = 0; i < 4; ++i) mx = fmaxf(mx, S[kt][qt][i]);
            mx = fmaxf(mx, __shfl_xor(mx, 16)); mx = fmaxf(mx, __shfl_xor(mx, 32));
            const float mnew = fmaxf(m[qt], mx), alpha = __expf(m[qt] - mnew);
            float rs = 0.f;
#pragma unroll
            for (int kt = 0; kt < 4; ++kt)
#pragma unroll
                for (int i = 0; i < 4; ++i) { const float sv = S[kt][qt][i]; const float pv = (sv > -1e29f) ? __expf(sv - mnew) : 0.f; S[kt][qt][i] = pv; rs += pv; }
            rs += __shfl_xor(rs, 16); rs += __shfl_xor(rs, 32);
            l[qt] = l[qt] * alpha + rs; m[qt] = mnew;
#pragma unroll
            for (int dt = 0; dt < 8; ++dt) O[dt][qt] *= alpha;
#pragma unroll
            for (int kk = 0; kk < 2; ++kk) {
                u32x4 w; w.x = pk2(S[2 * kk][qt][0], S[2 * kk][qt][1]); w.y = pk2(S[2 * kk][qt][2], S[2 * kk][qt][3]);
                w.z = pk2(S[2 * kk + 1][qt][0], S[2 * kk + 1][qt][1]); w.w = pk2(S[2 * kk + 1][qt][2], S[2 * kk + 1][qt][3]);
                Pf[kk][qt] = __builtin_bit_cast(s16x8, w);
            }
        }
        const LAS unsigned char* vb = lds + A_VB0 + buf * A_VBSZ + (4 * g4 + q4) * VSTR + p4 * 8;
#pragma unroll
        for (int kk = 0; kk < 2; ++kk)
#pragma unroll
            for (int dt = 0; dt < 8; ++dt) {
                const s16x4 v0 = vtr(vb + (kk * 32) * VSTR + dt * 32);
                const s16x4 v1 = vtr(vb + (kk * 32 + 16) * VSTR + dt * 32);
                const s16x8 vf = (s16x8){v0[0], v0[1], v0[2], v0[3], v1[0], v1[1], v1[2], v1[3]};
#pragma unroll
                for (int qt = 0; qt < QT; ++qt) O[dt][qt] = __builtin_amdgcn_mfma_f32_16x16x32_bf16(vf, Pf[kk][qt], O[dt][qt], 0, 0, 0);
            }
        if (!has_next) break;
        kv_lstore<DQK>(lds, buf ^ 1, kr, vr);
        __syncthreads();
        buf ^= 1; jt = jn;
    }
}

template <int QT>
__device__ __forceinline__ void attn_init(f32x4 (&O)[8][QT], float (&m)[QT], float (&l)[QT]) {
#pragma unroll
    for (int qt = 0; qt < QT; ++qt) { m[qt] = NEG_BIG; l[qt] = 0.f;
#pragma unroll
        for (int dt = 0; dt < 8; ++dt) O[dt][qt] = (f32x4){0.f, 0.f, 0.f, 0.f}; }
}
template <int QT>
__device__ __forceinline__ void attn_store(const f32x4 (&O)[8][QT], const float (&l)[QT], bf16_t* const (&orow)[QT]) {
    const int g4 = (ltid() & 63) >> 4;
#pragma unroll
    for (int qt = 0; qt < QT; ++qt) { const float inv = 1.0f / fmaxf(l[qt], 1e-30f);
#pragma unroll
        for (int dt = 0; dt < 8; ++dt) { const f32x4 o = O[dt][qt] * inv; u32x2 w; w.x = pk2(o[0], o[1]); w.y = pk2(o[2], o[3]); *(u32x2*)(orow[qt] + dt * 16 + 4 * g4) = w; } }
}
__device__ __forceinline__ int qc_order(int t, int per, int nq) { const int r = t / per; const int q = r % nq; return (r / nq) * 0 + ((r & 1) ? q : (nq - 1 - q)); }

__device__ __forceinline__ void moba_kmean_phase(const Params& p, LAS unsigned char* lds) {
    const int tid = ltid(); LAS float* R = (LAS float*)lds;
    for (int job = blockIdx.x; job < NB * NHEAD * 8; job += gridDim.x) {
        const int blk = job & 7, h = (job >> 3) & 15, b = job >> 7;
        const int d8 = (tid & 15) * 8, jg = tid >> 4;
        float acc[8];
#pragma unroll
        for (int e = 0; e < 8; ++e) acc[e] = 0.f;
#pragma unroll
        for (int i = 0; i < 8; ++i) {
            const int j = jg + 32 * i;
            const s16x8 v = *(const s16x8*)(p.proj + (size_t)(b * SEQ + blk * 256 + j) * MOBA_LD + 2048 + h * HD + d8);
#pragma unroll
            for (int e = 0; e < 8; ++e) acc[e] += bf2f((bf16_t)v[e]);
        }
        __syncthreads();
#pragma unroll
        for (int e = 0; e < 8; ++e) R[jg * 128 + d8 + e] = acc[e];
        __syncthreads();
        if (tid < 128) { float s = 0.f; for (int g = 0; g < 32; ++g) s += R[g * 128 + tid]; p.kmean[(size_t)job * 128 + tid] = s * (1.0f / 256.0f); }
    }
    __syncthreads();
}

__device__ __forceinline__ void moba_attn_phase(const Params& p, LAS unsigned char* lds) {
    const int tid = ltid(), lane = tid & 63, wave = tid >> 6, fr = lane & 15, g4 = lane >> 4;
    LAS unsigned* RM = (LAS unsigned*)(lds + A_RMASK); LAS unsigned* UM = (LAS unsigned*)(lds + A_UMASK);
    for (int t = blockIdx.x; t < NB * NHEAD * 8; t += gridDim.x) {
        const int per = NB * NHEAD, n = (t / per) < 4 ? (7 - t / per) : (t / per - 4), bh = t % per, b = bh >> 4, h = bh & 15;
        __syncthreads();
        build_lut(lds, p.rel_bias, h, 1);
        if (tid == 0) UM[0] = 0u;
        __syncthreads();
        if (tid < 256) {
            unsigned mask = 1u << n;
            if (n <= 3) mask |= (1u << n) - 1u;
            else {
                const bf16_t* qr = p.proj + (size_t)(b * SEQ + n * 256 + tid) * MOBA_LD + h * HD;
                float g0 = 0.f, g1 = 0.f, g2 = 0.f, g3 = 0.f, g5 = 0.f, g6 = 0.f, g7 = 0.f;
                float gate[7];
#pragma unroll
                for (int j = 0; j < 7; ++j) gate[j] = 0.f;
                const float* km = p.kmean + (size_t)(b * NHEAD + h) * 8 * 128;
                for (int d8 = 0; d8 < 128; d8 += 8) {
                    const s16x8 qv = *(const s16x8*)(qr + d8);
#pragma unroll
                    for (int j = 0; j < 7; ++j) if (j < n) {
                        const f32x4 k0 = *(const f32x4*)(km + j * 128 + d8), k1 = *(const f32x4*)(km + j * 128 + d8 + 4);
#pragma unroll
                        for (int e = 0; e < 4; ++e) gate[j] += bf2f((bf16_t)qv[e]) * k0[e] + bf2f((bf16_t)qv[4 + e]) * k1[e];
                    }
                }
                (void)g0; (void)g1; (void)g2; (void)g3; (void)g5; (void)g6; (void)g7;
                unsigned picked = 0u;
#pragma unroll
                for (int r = 0; r < 3; ++r) {
                    float best = -3e38f; int bi = 0;
#pragma unroll
                    for (int j = 0; j < 7; ++j) if (j < n && !((picked >> j) & 1u) && gate[j] > best) { best = gate[j]; bi = j; }
                    picked |= 1u << bi;
                }
                mask |= picked;
            }
            RM[tid] = mask; atomicOr((unsigned*)UM, mask);
        }
        __syncthreads();
        const unsigned um = UM[0];
        unsigned long long act = 0ull;
        for (int j = 0; j <= n; ++j) if ((um >> j) & 1u) act |= 0xFull << (4 * j);
        int qpos[2]; unsigned rmask[2]; int gl[2]; s16x8 Qf[2][4]; bf16_t* orow[2];
#pragma unroll
        for (int qt = 0; qt < 2; ++qt) {
            const int r = wave * 32 + qt * 16 + fr; qpos[qt] = n * 256 + r; rmask[qt] = RM[r]; gl[qt] = 0;
            const bf16_t* qr = p.proj + (size_t)(b * SEQ + qpos[qt]) * MOBA_LD + h * HD + g4 * 8;
#pragma unroll
            for (int ks = 0; ks < 4; ++ks) Qf[qt][ks] = *(const s16x8*)(qr + ks * 32);
            orow[qt] = p.att + (size_t)(b * SEQ + qpos[qt]) * DM + h * HD;
        }
        KVSrc<128> src{p.proj + (size_t)b * SEQ * MOBA_LD + 2048 + h * HD, (size_t)MOBA_LD, nullptr, 0, p.proj + (size_t)b * SEQ * MOBA_LD + 4096 + h * HD, (size_t)MOBA_LD, SEQ};
        MaskCfg mc{1, 0, 1 << 30, 8, SEQ, 0.08838834764831845f};
        f32x4 O[8][2]; float m[2], l[2];
        attn_init<2>(O, m, l);
        attn_pass<128, 2, true>(lds, src, act, mc, Qf, O, m, l, qpos, rmask, gl);
        attn_store<2>(O, l, orow);
    }
    __syncthreads();
}

__device__ __forceinline__ void swa_attn_phase(const Params& p, LAS unsigned char* lds) {
    const int tid = ltid(), lane = tid & 63, wave = tid >> 6, fr = lane & 15, g4 = lane >> 4;
    for (int t = blockIdx.x; t < NB * 2 * 64; t += gridDim.x) {
        const int qc = t >> 3, bk = t & 7, b = bk >> 1, hk = bk & 1, q0 = qc * 32;
        __syncthreads();
        build_lut(lds, p.rel_bias, hk * 8, 8);
        __syncthreads();
        int qpos[2]; unsigned rmask[2]; int gl[2]; s16x8 Qf[2][4]; bf16_t* orow[2];
        const int head = hk * 8 + wave;
#pragma unroll
        for (int qt = 0; qt < 2; ++qt) {
            qpos[qt] = q0 + qt * 16 + fr; rmask[qt] = 0xFFFFFFFFu; gl[qt] = wave;
            const bf16_t* qr = p.proj + (size_t)(b * SEQ + qpos[qt]) * SWA_LD + head * HD + g4 * 8;
#pragma unroll
            for (int ks = 0; ks < 4; ++ks) Qf[qt][ks] = *(const s16x8*)(qr + ks * 32);
            orow[qt] = p.att + (size_t)(b * SEQ + qpos[qt]) * DM + head * HD;
        }
        KVSrc<128> src{p.proj + (size_t)b * SEQ * SWA_LD + 2048 + hk * HD, (size_t)SWA_LD, nullptr, 0, p.proj + (size_t)b * SEQ * SWA_LD + 2304 + hk * HD, (size_t)SWA_LD, SEQ};
        MaskCfg mc{1, 0, 128, 31, SEQ, 0.08838834764831845f};
        const int tlo = (q0 - 127 < 0 ? 0 : q0 - 127) >> 6, thi = (q0 + 31) >> 6;
        unsigned long long act = 0ull;
        for (int j = tlo; j <= thi; ++j) act |= 1ull << j;
        f32x4 O[8][2]; float m[2], l[2];
        attn_init<2>(O, m, l);
        const float sink = p.swa_sinks[head];
        m[0] = sink; m[1] = sink; l[0] = 1.f; l[1] = 1.f;
        attn_pass<128, 2, true>(lds, src, act, mc, Qf, O, m, l, qpos, rmask, gl);
        attn_store<2>(O, l, orow);
    }
    __syncthreads();
}

__device__ __forceinline__ void mla_norm_phase(const Params& p) {
    const int tid = ltid(), lane = tid & 63, wave = tid >> 6;
    for (int row = blockIdx.x * 8 + wave; row < NTOK; row += gridDim.x * 8) {
        const float* cr = p.cdown + (size_t)row * MLA_DN_LD;
#pragma unroll
        for (int part = 0; part < 2; ++part) {
            f32x4 v[2]; float s = 0.f;
#pragma unroll
            for (int i = 0; i < 2; ++i) { v[i] = *(const f32x4*)(cr + part * 512 + i * 256 + lane * 4); s += (v[i][0] * v[i][0] + v[i][1] * v[i][1]) + (v[i][2] * v[i][2] + v[i][3] * v[i][3]); }
#pragma unroll
            for (int o = 32; o > 0; o >>= 1) s += __shfl_xor(s, o);
            const float r = rsqrtf(s * (1.0f / 512.0f) + 1e-6f);
            const float* gw = part ? p.kv_norm : p.q_norm; bf16_t* dst = (part ? p.ckvn : p.cqn) + (size_t)row * 512;
#pragma unroll
            for (int i = 0; i < 2; ++i) { const int c = i * 256 + lane * 4; const f32x4 gg = *(const f32x4*)(gw + c); const f32x4 o = v[i] * r * gg;
                u32x2 w; w.x = pk2(o[0], o[1]); w.y = pk2(o[2], o[3]); *(u32x2*)(dst + c) = w; }
        }
        if (lane < 32) {
            const int s = row % SEQ; const float t1 = cr[1024 + lane], t2 = cr[1024 + 32 + lane];
            const float c = p.rope[s * 64 + lane], sn = p.rope[s * 64 + 32 + lane];
            p.krope[(size_t)row * 64 + lane] = f2bf(t1 * c - t2 * sn); p.krope[(size_t)row * 64 + 32 + lane] = f2bf(t1 * sn + t2 * c);
        }
    }
}

__device__ __forceinline__ void mla_attn_phase(const Params& p, LAS unsigned char* lds) {
    const int tid = ltid(), lane = tid & 63, wave = tid >> 6, fr = lane & 15, g4 = lane >> 4;
    for (int t = blockIdx.x; t < NB * NHEAD * 8; t += gridDim.x) {
        const int per = NB * NHEAD, n = (t / per) < 4 ? (7 - t / per) : (t / per - 4), bh = t % per, b = bh >> 4, h = bh & 15;
        int qpos[2]; unsigned rmask[2]; int gl[2]; s16x8 Qf[2][6]; bf16_t* orow[2];
#pragma unroll
        for (int qt = 0; qt < 2; ++qt) {
            const int r = wave * 32 + qt * 16 + fr; qpos[qt] = n * 256 + r; rmask[qt] = 0xFFFFFFFFu; gl[qt] = 0;
            const bf16_t* qr = p.proj + (size_t)(b * SEQ + qpos[qt]) * MLA_Q_LD + h * 192 + g4 * 8;
#pragma unroll
            for (int ks = 0; ks < 6; ++ks) Qf[qt][ks] = *(const s16x8*)(qr + ks * 32);
            const float* rp = p.rope + qpos[qt] * 64 + g4 * 8;
            s16x8 a = Qf[qt][4], c2 = Qf[qt][5];
#pragma unroll
            for (int e = 0; e < 8; ++e) { const float t1 = bf2f((bf16_t)a[e]), t2 = bf2f((bf16_t)c2[e]), cs = rp[e], sn = rp[32 + e];
                a[e] = (short)f2bf(t1 * cs - t2 * sn); c2[e] = (short)f2bf(t1 * sn + t2 * cs); }
            Qf[qt][4] = a; Qf[qt][5] = c2;
            orow[qt] = p.att + (size_t)(b * SEQ + qpos[qt]) * DM + h * HD;
        }
        const bf16_t* kvb = p.proj + (size_t)NTOK * MLA_Q_LD + (size_t)b * SEQ * MLA_KV_LD + h * 256;
        KVSrc<192> src{kvb, (size_t)MLA_KV_LD, p.krope + (size_t)b * SEQ * 64, 64, kvb + 128, (size_t)MLA_KV_LD, SEQ};
        MaskCfg mc{1, 0, 1 << 30, 31, SEQ, 0.07216878364870322f};
        unsigned long long act = 0ull;
        for (int j = 0; j < 4 * (n + 1); ++j) act |= 1ull << j;
        f32x4 O[8][2]; float m[2], l[2];
        attn_init<2>(O, m, l);
        attn_pass<192, 2, false>(lds, src, act, mc, Qf, O, m, l, qpos, rmask, gl);
        attn_store<2>(O, l, orow);
    }
    __syncthreads();
}

__device__ __forceinline__ float gelu_tanh(float x) { const float u = 0.7978845608028654f * (x + 0.044715f * x * x * x); const float e = __expf(2.0f * u); const float th = 1.0f - 2.0f / (e + 1.0f); return 0.5f * x * (1.0f + th); }

__device__ __forceinline__ void nsa_cmp1_phase(const Params& p) {
    const int tid = ltid(), lane = tid & 63, wave = tid >> 6, fr = lane & 15, g4 = lane >> 4;
    for (int t = blockIdx.x; t < 128; t += gridDim.x) {
        const int nq = t & 3, bk = (t >> 2) & 15, kv = t >> 6, b = bk >> 2, hk = bk & 3;
        int c = wave * 16 + fr; const int cc = c > 126 ? 126 : c;
        const bf16_t* arow = p.proj + (size_t)(b * SEQ + cc * 16) * NSA_LD + 2048 + kv * 512 + hk * HD + g4 * 8;
        const bf16_t* brow = p.w_cmp1 + (size_t)kv * 256 * 4096 + (size_t)(nq * 64 + fr) * 4096 + g4 * 8;
        f32x4 acc[4];
#pragma unroll
        for (int i = 0; i < 4; ++i) acc[i] = (f32x4){0.f, 0.f, 0.f, 0.f};
#pragma unroll 2
        for (int ks = 0; ks < 128; ++ks) {
            const s16x8 af = *(const s16x8*)(arow + (size_t)(ks >> 2) * NSA_LD + (ks & 3) * 32);
#pragma unroll
            for (int nt = 0; nt < 4; ++nt) { const s16x8 bf = *(const s16x8*)(brow + (size_t)nt * 16 * 4096 + ks * 32);
                acc[nt] = __builtin_amdgcn_mfma_f32_16x16x32_bf16(bf, af, acc[nt], 0, 0, 0); }
        }
        bf16_t* orow = p.cmp_hid + ((size_t)(kv * 16 + bk) * 128 + c) * 256 + nq * 64;
#pragma unroll
        for (int nt = 0; nt < 4; ++nt) { const int n0 = nt * 16 + 4 * g4; const f32x4 pb = *(const f32x4*)(p.pe_bias + kv * 256 + nq * 64 + n0);
            const f32x4 v = acc[nt] + pb; u32x2 w; w.x = pk2(gelu_tanh(v[0]), gelu_tanh(v[1])); w.y = pk2(gelu_tanh(v[2]), gelu_tanh(v[3])); *(u32x2*)(orow + n0) = w; }
    }
}
__device__ __forceinline__ void nsa_cmp2_phase(const Params& p) {
    const int tid = ltid(), lane = tid & 63, wave = tid >> 6, fr = lane & 15, g4 = lane >> 4;
    for (int t = blockIdx.x; t < 32; t += gridDim.x) {
        const int bk = t & 15, kv = t >> 4; const int c = wave * 16 + fr;
        const bf16_t* arow = p.cmp_hid + ((size_t)(kv * 16 + bk) * 128 + c) * 256 + g4 * 8;
        const bf16_t* brow = p.w_cmp2 + (size_t)kv * 128 * 256 + (size_t)fr * 256 + g4 * 8;
        f32x4 acc[8];
#pragma unroll
        for (int i = 0; i < 8; ++i) acc[i] = (f32x4){0.f, 0.f, 0.f, 0.f};
#pragma unroll
        for (int ks = 0; ks < 8; ++ks) {
            const s16x8 af = *(const s16x8*)(arow + ks * 32);
#pragma unroll
            for (int nt = 0; nt < 8; ++nt) { const s16x8 bf = *(const s16x8*)(brow + (size_t)nt * 16 * 256 + ks * 32);
                acc[nt] = __builtin_amdgcn_mfma_f32_16x16x32_bf16(bf, af, acc[nt], 0, 0, 0); }
        }
        bf16_t* orow = p.kcvc + ((size_t)(kv * 16 + bk) * 128 + c) * 128;
#pragma unroll
        for (int nt = 0; nt < 8; ++nt) { f32x4 v = acc[nt]; if (c >= 127) v = (f32x4){0.f, 0.f, 0.f, 0.f};
            u32x2 w; w.x = pk2(v[0], v[1]); w.y = pk2(v[2], v[3]); *(u32x2*)(orow + nt * 16 + 4 * g4) = w; }
    }
}

__device__ __forceinline__ void nsa_attn_phase(const Params& p, LAS unsigned char* lds) {
    const int tid = ltid(), lane = tid & 63, wave = tid >> 6, fr = lane & 15, g4 = lane >> 4;
    LAS unsigned* RM = (LAS unsigned*)(lds + A_RMASK); LAS unsigned* UM = (LAS unsigned*)(lds + A_UMASK);
    LAS float* IMPG = (LAS float*)(lds + A_IMP);
    LAS float* IMPF = (LAS float*)(lds + A_IMPF);
    for (int t = blockIdx.x; t < NB * 4 * 64; t += gridDim.x) {
        const int per = 16, r_ = t / per, qc = (r_ & 1) ? (r_ >> 1) : (63 - (r_ >> 1)), bk = t % per, b = bk >> 2, hk = bk & 3, q0 = qc * 32;
        __syncthreads();
        build_lut(lds, p.rel_bias, hk * 4, 4);
        if (tid == 0) UM[0] = 0u;
        __syncthreads();
        const int g = wave >> 1, qi = (wave & 1) * 16 + fr, head = hk * 4 + g;
        int qpos[1] = {q0 + qi}; unsigned rmask[1] = {0xFFFFFFFFu}; int gl[1] = {g}; s16x8 Qf[1][4];
        const size_t tok = (size_t)(b * SEQ + qpos[0]);
        {
            const bf16_t* qr = p.proj + tok * NSA_LD + head * HD + g4 * 8;
#pragma unroll
            for (int ks = 0; ks < 4; ++ks) Qf[0][ks] = *(const s16x8*)(qr + ks * 32);
        }
        float gate[3];
#pragma unroll
        for (int br = 0; br < 3; ++br) { const float z = bf2f(p.proj[tok * NSA_LD + 5120 + head * 3 + br]); gate[br] = 1.0f / (1.0f + __expf(-z)); }
        f32x4 OT[8];
#pragma unroll
        for (int dt = 0; dt < 8; ++dt) OT[dt] = (f32x4){0.f, 0.f, 0.f, 0.f};
        f32x4 O[8][1]; float m[1], l[1];
        const float scale = 0.08838834764831845f;
        {
            const bf16_t* kc = p.kcvc + (size_t)(0 * 16 + bk) * 128 * 128; const bf16_t* vc = p.kcvc + (size_t)(1 * 16 + bk) * 128 * 128;
            KVSrc<128> src{kc, 128, nullptr, 0, vc, 128, 127};
            MaskCfg mc{16, 31, 1 << 30, 31, 127, scale};
            const bool two = (2 * qc >= 64);
            unsigned long long act = two ? 3ull : 1ull;
            attn_init<1>(O, m, l);
            attn_pass<128, 1, true>(lds, src, act, mc, Qf, O, m, l, qpos, rmask, gl);
            const float inv = 1.0f / fmaxf(l[0], 1e-30f);
#pragma unroll
            for (int dt = 0; dt < 8; ++dt) OT[dt] += O[dt][0] * (inv * gate[0]);
            float carry = 0.f;
#pragma unroll
            for (int jt = 0; jt < 2; ++jt) {
                if (jt == 0 || two) {
                    f32x4 S[4][1];
                    qk_tile<128, 1, true>(lds, jt, jt, Qf, S, mc, qpos, rmask, gl);
                    float p3[4], s4[4];
#pragma unroll
                    for (int kt = 0; kt < 4; ++kt) {
                        float pv[4];
#pragma unroll
                        for (int i = 0; i < 4; ++i) pv[i] = (S[kt][0][i] > -1e29f) ? __expf(S[kt][0][i] - m[0]) * inv : 0.f;
                        s4[kt] = (pv[0] + pv[1]) + (pv[2] + pv[3]); p3[kt] = pv[3];
                    }
#pragma unroll
                    for (int kt = 0; kt < 4; ++kt) {
                        const float fromlane = __shfl(p3[kt], (lane + 48) & 63);
                        const float wrap = __shfl(kt > 0 ? p3[kt > 0 ? kt - 1 : 0] : carry, (lane + 48) & 63);
                        const float prev = (g4 > 0) ? fromlane : wrap;
                        IMPG[(g * 32 + qi) * 32 + jt * 16 + kt * 4 + g4] = s4[kt] + prev;
                    }
                    carry = p3[3];
                } else {
#pragma unroll
                    for (int kt = 0; kt < 4; ++kt) IMPG[(g * 32 + qi) * 32 + 16 + kt * 4 + g4] = 0.f;
                }
            }
        }
        __syncthreads();
        for (int i = tid; i < 32 * 32; i += 512) IMPF[i] = (IMPG[i] + IMPG[1024 + i]) + (IMPG[2048 + i] + IMPG[3072 + i]);
        __syncthreads();
        if (tid < 32) {
            const int qb = (q0 + tid) >> 6;
            unsigned sel = 1u | (1u << qb); if (qb >= 1) sel |= 1u << (qb - 1);
            int cnt = __builtin_popcount(sel);
            const unsigned valid = (qb >= 31) ? 0xFFFFFFFFu : ((2u << qb) - 1u);
            while (cnt < 16) {
                float best = -1.f; int bi = -1;
                for (int j = 0; j < 32; ++j) { const float v = IMPF[tid * 32 + j]; if (((valid >> j) & 1u) && !((sel >> j) & 1u) && v > best) { best = v; bi = j; } }
                if (bi < 0) break;
                sel |= 1u << bi; ++cnt;
            }
            RM[tid] = sel; atomicOr((unsigned*)UM, sel);
        }
        __syncthreads();
        {
            rmask[0] = RM[qi];
            const unsigned um = UM[0];
            const int thi = (q0 + 31) >> 6;
            unsigned long long act = 0ull;
            for (int j = 0; j <= thi; ++j) if ((um >> j) & 1u) act |= 1ull << j;
            KVSrc<128> src{p.proj + (size_t)b * SEQ * NSA_LD + 3072 + hk * HD, (size_t)NSA_LD, nullptr, 0, p.proj + (size_t)b * SEQ * NSA_LD + 3584 + hk * HD, (size_t)NSA_LD, SEQ};
            MaskCfg mc{1, 0, 1 << 30, 6, SEQ, scale};
            attn_init<1>(O, m, l);
            attn_pass<128, 1, true>(lds, src, act, mc, Qf, O, m, l, qpos, rmask, gl);
            const float inv = 1.0f / fmaxf(l[0], 1e-30f);
#pragma unroll
            for (int dt = 0; dt < 8; ++dt) OT[dt] += O[dt][0] * (inv * gate[1]);
        }
        {
            rmask[0] = 0xFFFFFFFFu;
            const int tlo = (q0 - 511 < 0 ? 0 : q0 - 511) >> 6, thi = (q0 + 31) >> 6;
            unsigned long long act = 0ull;
            for (int j = tlo; j <= thi; ++j) act |= 1ull << j;
            KVSrc<128> src{p.proj + (size_t)b * SEQ * NSA_LD + 4096 + hk * HD, (size_t)NSA_LD, nullptr, 0, p.proj + (size_t)b * SEQ * NSA_LD + 4608 + hk * HD, (size_t)NSA_LD, SEQ};
            MaskCfg mc{1, 0, 512, 31, SEQ, scale};
            attn_init<1>(O, m, l);
            attn_pass<128, 1, true>(lds, src, act, mc, Qf, O, m, l, qpos, rmask, gl);
            const float inv = 1.0f / fmaxf(l[0], 1e-30f);
#pragma unroll
            for (int dt = 0; dt < 8; ++dt) OT[dt] += O[dt][0] * (inv * gate[2]);
        }
        bf16_t* orow = p.att + tok * DM + head * HD;
#pragma unroll
        for (int dt = 0; dt < 8; ++dt) { u32x2 w; w.x = pk2(OT[dt][0], OT[dt][1]); w.y = pk2(OT[dt][2], OT[dt][3]); *(u32x2*)(orow + dt * 16 + 4 * g4) = w; }
    }
    __syncthreads();
}

template <class Epi>
__device__ __forceinline__ void run_gemm(LAS unsigned char* lds, const bf16_t* A, const bf16_t* Bt, int N, int K, const Epi& E) {
    pg8::Gemm g{A, Bt, NTOK, N, K}; pg8::StaticOrder S; S.init(NTOK, N, (int)gridDim.x, (int)blockIdx.x);
    pg8::gemm_phase<Epi, pg8::StaticOrder, false>(lds, g, S, E, nullptr);
    __syncthreads();
}

__global__ void __launch_bounds__(512) mega(Params p_unused) {
    extern __shared__ __attribute__((aligned(16))) unsigned char lds_raw[];
    LAS unsigned char* lds = (LAS unsigned char*)lds_raw;
    cg::grid_group grid = cg::this_grid();
    KP kp = (KP)__builtin_amdgcn_kernarg_segment_ptr();
    phase0(PK(kp), lds);
    grid.sync();
#pragma unroll 1
    for (int L = 0; L < 4; ++L) {
        {
            const Params& p = PK(kp);
            const bf16_t* win = (L == 0) ? p.w_moba_qkv : (L == 1) ? p.w_swa_qkv : p.w_nsa_in;
            const int nin = (L == 0) ? MOBA_LD : (L == 1) ? SWA_LD : NSA_LD;
            if (L != 3) run_gemm(lds, p.xb, win, nin, DM, pg8::EpiBf16{p.proj, nin});
            else run_gemm(lds, p.xb, p.w_mla_down, MLA_DN_LD, DM, pg8::EpiF32{p.cdown, MLA_DN_LD});
        }
        grid.sync();
        if (L == 0) {
            moba_kmean_phase(PK(kp), lds);
            grid.sync();
            moba_attn_phase(PK(kp), lds);
        } else if (L == 1) {
            swa_attn_phase(PK(kp), lds);
        } else if (L == 2) {
            nsa_cmp1_phase(PK(kp));
            grid.sync();
            nsa_cmp2_phase(PK(kp));
            grid.sync();
            nsa_attn_phase(PK(kp), lds);
        } else {
            mla_norm_phase(PK(kp));
            grid.sync();
#pragma unroll 1
            for (int i = 0; i < 2; ++i) {
                const Params& p = PK(kp);
                run_gemm(lds, i ? p.ckvn : p.cqn, i ? p.w_mla_ukv : p.w_mla_uq, i ? MLA_KV_LD : MLA_Q_LD, 512,
                         pg8::EpiBf16{p.proj + (i ? (size_t)NTOK * MLA_Q_LD : 0), i ? MLA_KV_LD : MLA_Q_LD});
            }
            grid.sync();
            mla_attn_phase(PK(kp), lds);
        }
        grid.sync();
        {
            const Params& p = PK(kp);
            const bf16_t* wo = (L == 0) ? p.w_moba_o : (L == 1) ? p.w_swa_o : (L == 2) ? p.w_nsa_o : p.w_mla_o;
            run_gemm(lds, p.att, wo, DM, DM, pg8::EpiRes{p.y, (L == 0) ? p.x : p.xf, DM, ALPHA_F});
        }
        grid.sync();
        { const Params& p = PK(kp); ln_phase(p.y, p.ln1_g + L * DM, p.ln1_b + L * DM, p.xf, p.xb); }
        grid.sync();
        { const Params& p = PK(kp); run_gemm(lds, p.xb, p.w_gu + (size_t)L * 2 * DFF * DM, 2 * DFF, DM, pg8::EpiSwiGLU{p.hid, DFF}); }
        grid.sync();
        { const Params& p = PK(kp); run_gemm(lds, p.hid, p.w_dn + (size_t)L * DM * DFF, DM, DFF, pg8::EpiRes{p.y, p.xf, DM, ALPHA_F}); }
        grid.sync();
        { const Params& p = PK(kp); ln_phase(p.y, p.ln2_g + L * DM, p.ln2_b + L * DM, (L == 3) ? p.out : p.xf, (L == 3) ? nullptr : p.xb); }
        if (L < 3) grid.sync();
    }
}

extern "C" void kernel_launch(void* const* d_in, const int* in_sizes, int n_in, void* d_out, int out_size, void* d_ws, size_t ws_size, hipStream_t stream) {
    (void)in_sizes; (void)n_in; (void)out_size;
    static int grid_blocks = 0;
    if (!grid_blocks) {
        int dev = 0, cus = 0, per_cu = 0;
        hipGetDevice(&dev);
        hipDeviceGetAttribute(&cus, hipDeviceAttributeMultiprocessorCount, dev);
        hipFuncSetAttribute((const void*)mega, hipFuncAttributeMaxDynamicSharedMemorySize, LDS_BYTES);
        hipOccupancyMaxActiveBlocksPerMultiprocessor(&per_cu, (const void*)mega, 512, LDS_BYTES);
        if (per_cu < 1) per_cu = 1;
        grid_blocks = cus * 1;
        (void)hipGetLastError();
    }
    const float* const* in = (const float* const*)d_in;
    Params p{};
    p.x = in[0]; p.rel_bias = in[1]; p.swa_sinks = in[5]; p.cmp_pos = in[8]; p.cmp_w1 = in[9];
    p.q_norm = in[13]; p.kv_norm = in[14];
    p.ln1_g = in[18]; p.ln1_b = in[19]; p.ln2_g = in[23]; p.ln2_b = in[24];
    p.out = (float*)d_out;
    unsigned char* ws = (unsigned char*)d_ws; size_t off = 0;
    auto take = [&](size_t bytes) { unsigned char* r = ws + off; off += (bytes + 255) & ~(size_t)255; return r; };
    int nj = 0, tiles = 0;
    auto job = [&](const float* src, int K, int N, int Npad, int blk, int stride, int offr, bf16_t* dst) {
        CvtJob& j = p.jobs[nj++]; j.src = src; j.dst = dst; j.K = K; j.N = N; j.Npad = Npad; j.blk = blk; j.stride = stride; j.off = offr; j.tile0 = tiles; j.pad = 0;
        tiles += (K / 64) * (Npad / 64);
    };
    auto plain = [&](const float* src, int K, int N, int Npad) { bf16_t* d = (bf16_t*)take((size_t)Npad * K * 2); job(src, K, N, Npad, Npad, Npad, 0, d); return (const bf16_t*)d; };
    p.w_moba_qkv = plain(in[2], DM, 6144, 6144);
    p.w_moba_o = plain(in[3], DM, DM, DM);
    p.w_swa_qkv = plain(in[4], DM, 2560, 2560);
    p.w_swa_o = plain(in[6], DM, DM, DM);
    p.w_nsa_in = plain(in[7], DM, 5168, NSA_LD);
    p.w_nsa_o = plain(in[11], DM, DM, DM);
    { bf16_t* d = (bf16_t*)take((size_t)2 * 256 * 4096 * 2); p.w_cmp1 = d;
      for (int kv = 0; kv < 2; ++kv) job(in[9] + (size_t)kv * 4096 * 256, 4096, 256, 256, 256, 256, 0, d + (size_t)kv * 256 * 4096); }
    { bf16_t* d = (bf16_t*)take((size_t)2 * 128 * 256 * 2); p.w_cmp2 = d;
      for (int kv = 0; kv < 2; ++kv) job(in[10] + (size_t)kv * 256 * 128, 256, 128, 128, 128, 128, 0, d + (size_t)kv * 128 * 256); }
    p.w_mla_down = plain(in[12], DM, 1088, MLA_DN_LD);
    p.w_mla_uq = plain(in[15], 512, 3072, 3072);
    p.w_mla_ukv = plain(in[16], 512, 4096, 4096);
    p.w_mla_o = plain(in[17], DM, DM, DM);
    { bf16_t* d = (bf16_t*)take((size_t)4 * 2 * DFF * DM * 2); p.w_gu = d;
      for (int L = 0; L < 4; ++L) { job(in[20] + (size_t)L * DM * DFF, DM, DFF, DFF, 128, 256, 0, d + (size_t)L * 2 * DFF * DM); job(in[21] + (size_t)L * DM * DFF, DM, DFF, DFF, 128, 256, 128, d + (size_t)L * 2 * DFF * DM); } }
    { bf16_t* d = (bf16_t*)take((size_t)4 * DM * DFF * 2); p.w_dn = d;
      for (int L = 0; L < 4; ++L) job(in[22] + (size_t)L * DFF * DM, DFF, DM, DM, DM, DM, 0, d + (size_t)L * DM * DFF); }
    p.njobs = nj; p.total_tiles = tiles;
    p.xb = (bf16_t*)take((size_t)NTOK * DM * 2);
    p.xf = (float*)take((size_t)NTOK * DM * 4);
    p.y = (float*)take((size_t)NTOK * DM * 4);
    p.cdown = p.y;
    p.proj = (bf16_t*)take((size_t)NTOK * 7168 * 2);
    p.hid = p.proj;
    p.att = (bf16_t*)take((size_t)NTOK * DM * 2);
    p.cqn = p.att; p.ckvn = p.att + (size_t)NTOK * 512;
    p.kmean = (float*)take((size_t)NB * NHEAD * 8 * 128 * 4);
    p.pe_bias = (float*)take(2 * 256 * 4);
    p.rope = (float*)take((size_t)SEQ * 64 * 4);
    p.cmp_hid = (bf16_t*)take((size_t)32 * 128 * 256 * 2);
    p.kcvc = (bf16_t*)take((size_t)32 * 128 * 128 * 2);
    p.krope = (bf16_t*)take((size_t)NTOK * 64 * 2);
    if (off > ws_size || nj > NJOBS) { fprintf(stderr, "kernel_launch: workspace too small (%zu > %zu) or jobs %d\n", off, ws_size, nj); return; }
    void* args[] = {&p};
    hipError_t e = hipLaunchCooperativeKernel((const void*)mega, dim3(grid_blocks), dim3(512), args, LDS_BYTES, stream);
    if (e != hipSuccess) fprintf(stderr, "cooperative launch failed: %s (grid %d)\n", hipGetErrorString(e), grid_blocks);
}
```

```cpp
#include <hip/hip_runtime.h>
#include <hip/hip_cooperative_groups.h>
#include <cstdio>
namespace cg = cooperative_groups;
namespace pg8 {
#define PG8_LAS __attribute__((address_space(3)))
typedef unsigned short bf16_t;
typedef short bf16x8 __attribute__((ext_vector_type(8)));
typedef float f32x4 __attribute__((ext_vector_type(4)));
typedef unsigned u32x4 __attribute__((ext_vector_type(4)));
constexpr int BM = 256, BK = 64, HALF = 128, HTB = HALF * BK * 2  , STAGE_BYTES = 8 * HTB, NXCD = 8, WGM = 8;

__host__ __device__ __forceinline__ int lds_byte(int r, int c) { const int st = (r >> 4) * 2 + (c >> 5), rr = r & 15, cc = c & 31, ob = rr * 64 + cc * 2; return st * 1024 + (ob ^ (((ob >> 9) & 1) << 5)); }
__host__ __device__ __forceinline__ void stage_rc(int b, int& R, int& C) { const int st = b / 1024, sb = b % 1024, swz = sb ^ (((sb >> 9) & 1) << 5); R = (st >> 1) * 16 + swz / 64; C = (st & 1) * 32 + (swz % 64) / 2; }
__host__ __device__ __forceinline__ int perm32(int rho) { const int n = rho >> 4, i = rho & 15; return 8 * (i >> 2) + 4 * n + (i & 3); }

struct Unit { int pm, pn; };
struct Gemm { const bf16_t* A; const bf16_t* Bt; int M, N, K; };

struct StaticOrder {
    int nM, nN, nwg, G, c;
    __host__ __device__ void init(int M, int N, int G_, int c_) { nM = M / BM; nN = N / BM; nwg = nM * nN; G = G_; c = c_; }
    __host__ __device__ bool next(int i, Unit& u) const {
        const long L = (long)i * G + c; if (L >= nwg) return false;
        int wgid = (int)L; { const int q = nwg / NXCD, r = nwg % NXCD, xcd = wgid % NXCD, off = wgid / NXCD; wgid = (xcd < r ? xcd * (q + 1) : r * (q + 1) + (xcd - r) * q) + off; }
        const int nig = WGM * nN, gid = wgid / nig, fm = gid * WGM, gsz = (nM - fm) < WGM ? (nM - fm) : WGM;
        u.pm = fm + ((wgid % nig) % gsz); u.pn = (wgid % nig) / gsz; return true;
    }
    __device__ __forceinline__ void a_ready(const Unit&) const {}
    __device__ __forceinline__ void done(const Unit&) const {}
};
__device__ __forceinline__ unsigned cvt_pk_bf16(float lo, float hi) { unsigned r; asm volatile("v_cvt_pk_bf16_f32 %0, %1, %2" : "=v"(r) : "v"(lo), "v"(hi)); return r; }
typedef float f32x2 __attribute__((ext_vector_type(2)));
struct EpiF32 {
    static constexpr bool PERM = false, AFTER_DRAIN = false;
    float* C; int ldc;
    __device__ __forceinline__ void operator()(const f32x4 (&acc)[2][2][4][2], const Unit& u, int wr, int wc, int fr, int fq) const {
        const int row0 = u.pm * BM + wr * 64 + fr, col0 = u.pn * BM + wc * 32 + 4 * fq;
#pragma unroll
        for (int ai = 0; ai < 2; ++ai)
#pragma unroll
            for (int m = 0; m < 4; ++m) { float* rowp = C + (size_t)(row0 + ai * HALF + m * 16) * ldc + col0;
#pragma unroll
                for (int bj = 0; bj < 2; ++bj)
#pragma unroll
                    for (int n = 0; n < 2; ++n) *(f32x4*)(rowp + bj * HALF + n * 16) = acc[ai][bj][m][n]; }
    }
};
struct EpiRes {
    static constexpr bool PERM = false, AFTER_DRAIN = false;
    float* C; const float* base; int ldc; float alpha;
    __device__ __forceinline__ void operator()(const f32x4 (&acc)[2][2][4][2], const Unit& u, int wr, int wc, int fr, int fq) const {
        const int row0 = u.pm * BM + wr * 64 + fr, col0 = u.pn * BM + wc * 32 + 4 * fq;
#pragma unroll
        for (int ai = 0; ai < 2; ++ai)
#pragma unroll
            for (int m = 0; m < 4; ++m) { const size_t off = (size_t)(row0 + ai * HALF + m * 16) * ldc + col0;
#pragma unroll
                for (int bj = 0; bj < 2; ++bj)
#pragma unroll
                    for (int n = 0; n < 2; ++n) { const f32x4 b = *(const f32x4*)(base + off + bj * HALF + n * 16);
                        *(f32x4*)(C + off + bj * HALF + n * 16) = b * alpha + acc[ai][bj][m][n]; } }
    }
};
struct EpiBf16 {
    static constexpr bool PERM = true, AFTER_DRAIN = false;
    bf16_t* O; int ldc;
    __device__ __forceinline__ void operator()(const f32x4 (&acc)[2][2][4][2], const Unit& u, int wr, int wc, int fr, int fq) const {
        const int row0 = u.pm * BM + wr * 64 + fr; const int col0 = u.pn * BM + wc * 32 + 8 * fq;
#pragma unroll
        for (int ai = 0; ai < 2; ++ai)
#pragma unroll
            for (int m = 0; m < 4; ++m) { bf16_t* rowp = O + (size_t)(row0 + ai * HALF + m * 16) * ldc + col0;
#pragma unroll
                for (int bj = 0; bj < 2; ++bj) { const f32x4 v0 = acc[ai][bj][m][0], v1 = acc[ai][bj][m][1];
                    u32x4 w; w.x = cvt_pk_bf16(v0[0], v0[1]); w.y = cvt_pk_bf16(v0[2], v0[3]); w.z = cvt_pk_bf16(v1[0], v1[1]); w.w = cvt_pk_bf16(v1[2], v1[3]);
                    *(u32x4*)(rowp + bj * HALF) = w; } }
    }
};
__device__ __forceinline__ float silu_f(float x) { return x * __builtin_amdgcn_rcpf(1.0f + __builtin_amdgcn_exp2f(x * -1.4426950408889634f)); }
__device__ __forceinline__ float swiglu_pre(float t, float up) { return (t * up) * __builtin_amdgcn_rcpf(1.0f + __builtin_amdgcn_exp2f(t)); }
struct EpiSwiGLU {
    static constexpr bool PERM = true, AFTER_DRAIN = false;
    bf16_t* H; int ldc;
    __device__ __forceinline__ void operator()(const f32x4 (&acc)[2][2][4][2], const Unit& u, int wr, int wc, int fr, int fq) const {
        const int row0 = u.pm * BM + wr * 64 + fr; const int col0 = u.pn * HALF + wc * 32 + 8 * fq;
#pragma unroll
        for (int ai = 0; ai < 2; ++ai)
#pragma unroll
            for (int m = 0; m < 4; ++m) { bf16_t* rowp = H + (size_t)(row0 + ai * HALF + m * 16) * ldc + col0;
                f32x4 h0, h1;
#pragma unroll
                for (int j = 0; j < 4; ++j) { h0[j] = swiglu_pre(acc[ai][0][m][0][j], acc[ai][1][m][0][j]); h1[j] = swiglu_pre(acc[ai][0][m][1][j], acc[ai][1][m][1][j]); }
                u32x4 w; w.x = cvt_pk_bf16(h0[0], h0[1]); w.y = cvt_pk_bf16(h0[2], h0[3]); w.z = cvt_pk_bf16(h1[0], h1[1]); w.w = cvt_pk_bf16(h1[2], h1[3]);
                *(u32x4*)rowp = w; }
    }
};

template <class Epi, class Sched, bool STAMP = false>
__device__ __forceinline__ void gemm_phase(PG8_LAS unsigned char* lds, const Gemm g, const Sched& S, const Epi& E, unsigned long long* stamps) {
    int tid_l = threadIdx.x; asm volatile("" : "+v"(tid_l)); const int tid = tid_l, wid = __builtin_amdgcn_readfirstlane(tid >> 6), lane = tid & 63, wr = wid >> 2, wc = wid & 3, fr = lane & 15, fq = lane >> 4;
    const int K = g.K, nt = K / BK;
    int ts_lo = 0, ts_hi = 0, nts = 0; const unsigned long long rt_entry = STAMP ? (unsigned long long)wall_clock64() : 0ull;
#define PG8_STAMP() do { if (STAMP && wid == 0 && nts < 64) { const unsigned long long _c = (unsigned long long)clock64(); \
        ts_lo = (lane == nts) ? (int)(unsigned)_c : ts_lo; ts_hi = (lane == nts) ? (int)(unsigned)(_c >> 32) : ts_hi; ++nts; } } while (0)
    PG8_STAMP();
    unsigned voffA[2], voffB[2];
#pragma unroll
    for (int i = 0; i < 2; ++i) { int R, C; stage_rc(tid * 16 + i * 8192, R, C); const int Rb = Epi::PERM ? ((R & ~31) + perm32(R & 31)) : R;
        voffA[i] = (unsigned)(R * K + C) * 2u; voffB[i] = (unsigned)(Rb * K + C) * 2u; }
    const size_t kstep = (size_t)(BK * 2);
    const size_t hstep = (size_t)HALF * K * 2;
    const size_t tstep = 2 * hstep;
    const unsigned ldsw = (unsigned)wid * 1024u;
    const int aoff = lds_byte(wr * 64 + fr, fq * 8), boff = lds_byte(wc * 32 + fr, fq * 8);
#define PG8_SA(b, h) (((b) * 2 + (h)) * HTB)
#define PG8_SB(b, h) ((4 + (b) * 2 + (h)) * HTB)
#define PG8_STAGE(bufoff, gbase, voff) do { _Pragma("unroll") for (int _i = 0; _i < 2; ++_i) \
        __builtin_amdgcn_global_load_lds((const unsigned*)((const char*)(gbase) + (voff)[_i]), (PG8_LAS unsigned*)(lds + (bufoff) + ldsw + _i * 8192), 16, 0, 0); } while (0)
#define PG8_LDA(dst, b, h) do { _Pragma("unroll") for (int m = 0; m < 4; ++m) _Pragma("unroll") for (int k = 0; k < 2; ++k) dst[m][k] = *(const PG8_LAS bf16x8*)(lds + PG8_SA(b, h) + aoff + m * 2048 + k * 1024); } while (0)
#define PG8_LDB(dst, b, h) do { _Pragma("unroll") for (int n = 0; n < 2; ++n) _Pragma("unroll") for (int k = 0; k < 2; ++k) dst[n][k] = *(const PG8_LAS bf16x8*)(lds + PG8_SB(b, h) + boff + n * 2048 + k * 1024); } while (0)
#define PG8_MMA(ai, bj, At, Bt) do { __builtin_amdgcn_s_setprio(1); _Pragma("unroll") for (int m = 0; m < 4; ++m) _Pragma("unroll") for (int n = 0; n < 2; ++n) _Pragma("unroll") for (int k = 0; k < 2; ++k) \
        acc[ai][bj][m][n] = __builtin_amdgcn_mfma_f32_16x16x32_bf16(Bt[n][k], At[m][k], acc[ai][bj][m][n], 0, 0, 0); __builtin_amdgcn_s_setprio(0); } while (0)
#define PG8_WAIT_V(n) asm volatile("s_waitcnt vmcnt(" #n ")" ::: "memory")
#define PG8_WAIT_L(n) asm volatile("s_waitcnt lgkmcnt(" #n ")" ::: "memory")
#define PG8_BAR __builtin_amdgcn_s_barrier()
#define PG8_SCHED __builtin_amdgcn_sched_barrier(0)
    Unit cur, nxt; int ui = 0;
    if (!S.next(0, cur)) return;
    f32x4 acc[2][2][4][2];
#pragma unroll
    for (int a = 0; a < 2; ++a)
#pragma unroll
        for (int b = 0; b < 2; ++b)
#pragma unroll
            for (int m = 0; m < 4; ++m)
#pragma unroll
                for (int n = 0; n < 2; ++n) acc[a][b][m][n] = (f32x4){0.f, 0.f, 0.f, 0.f};
    bf16x8 At[4][2], B0[2][2], B1[2][2];
    const char* cA = (const char*)g.A + (size_t)cur.pm * tstep; const char* cB = (const char*)g.Bt + (size_t)cur.pn * tstep;
    S.a_ready(cur);
    PG8_STAGE(PG8_SB(0, 0), cB, voffB); PG8_STAGE(PG8_SA(0, 0), cA, voffA); PG8_STAGE(PG8_SB(0, 1), cB + hstep, voffB); PG8_STAGE(PG8_SA(0, 1), cA + hstep, voffA);
    if (wr == 1) PG8_BAR;
    PG8_WAIT_V(4); PG8_BAR;
    PG8_STAGE(PG8_SB(1, 0), cB + kstep, voffB); PG8_STAGE(PG8_SA(1, 0), cA + kstep, voffA); PG8_STAGE(PG8_SB(1, 1), cB + hstep + kstep, voffB);
    PG8_WAIT_V(6); PG8_BAR;
    PG8_STAMP();
    for (;;) {
        const bool has_next = S.next(ui + 1, nxt);
        const char* nA = has_next ? (const char*)g.A + (size_t)nxt.pm * tstep : cA; const char* nB = has_next ? (const char*)g.Bt + (size_t)nxt.pn * tstep : cB;
        for (int t = 0; t < nt; t += 2) {
            const bool last = (t == nt - 2);
            const char* a1 = cA + (size_t)(t + 1) * kstep;
            const char* a2 = last ? nA : cA + (size_t)(t + 2) * kstep; const char* b2 = last ? nB : cB + (size_t)(t + 2) * kstep;
            const char* a3 = a2 + kstep; const char* b3 = b2 + kstep;
            if (last && has_next) S.a_ready(nxt);
            PG8_LDB(B0, 0, 0); PG8_SCHED; PG8_LDA(At, 0, 0); PG8_STAGE(PG8_SA(1, 1), a1 + hstep, voffA);
            PG8_WAIT_L(8); PG8_BAR; PG8_WAIT_L(0); PG8_MMA(0, 0, At, B0); PG8_BAR; PG8_SCHED;
            PG8_LDB(B1, 0, 1); PG8_STAGE(PG8_SB(0, 0), b2, voffB);
            PG8_BAR; PG8_WAIT_L(0); PG8_MMA(0, 1, At, B1); PG8_BAR;
            PG8_LDA(At, 0, 1); PG8_STAGE(PG8_SA(0, 0), a2, voffA);
            PG8_BAR; PG8_WAIT_L(0); PG8_MMA(1, 0, At, B0); PG8_BAR; PG8_SCHED;
            PG8_STAGE(PG8_SB(0, 1), b2 + hstep, voffB);
            PG8_WAIT_V(6); PG8_BAR; PG8_MMA(1, 1, At, B1); PG8_BAR;
            PG8_LDB(B0, 1, 0); PG8_SCHED; PG8_LDA(At, 1, 0); PG8_STAGE(PG8_SA(0, 1), a2 + hstep, voffA);
            PG8_WAIT_L(8); PG8_BAR; PG8_WAIT_L(0); PG8_MMA(0, 0, At, B0); PG8_BAR; PG8_SCHED;
            PG8_LDB(B1, 1, 1); PG8_STAGE(PG8_SB(1, 0), b3, voffB);
            PG8_BAR; PG8_WAIT_L(0); PG8_MMA(0, 1, At, B1); PG8_BAR;
            PG8_LDA(At, 1, 1); PG8_STAGE(PG8_SA(1, 0), a3, voffA);
            PG8_BAR; PG8_WAIT_L(0); PG8_MMA(1, 0, At, B0); PG8_BAR; PG8_SCHED;
            PG8_STAGE(PG8_SB(1, 1), b3 + hstep, voffB);
            PG8_WAIT_V(6); PG8_BAR; PG8_MMA(1, 1, At, B1); PG8_BAR;
        }
        PG8_STAMP();
        if constexpr (!Epi::AFTER_DRAIN) { E(acc, cur, wr, wc, fr, fq); S.done(cur); }
        PG8_STAMP();
        if (!has_next) break;
#pragma unroll
        for (int a = 0; a < 2; ++a)
#pragma unroll
            for (int b = 0; b < 2; ++b)
#pragma unroll
                for (int m = 0; m < 4; ++m)
#pragma unroll
                    for (int n = 0; n < 2; ++n) acc[a][b][m][n] = (f32x4){0.f, 0.f, 0.f, 0.f};
        cur = nxt; cA = nA; cB = nB; ++ui;
    }
    PG8_WAIT_V(0);
    if (wr == 0) PG8_BAR;
    PG8_BAR;
    if constexpr (Epi::AFTER_DRAIN) { E.fused(acc, cur, wr, wc, fr, fq, lds, wid, lane); S.done(cur); }
    PG8_STAMP();
    if (STAMP && wid == 0) { stamps[lane] = lane < nts ? (((unsigned long long)(unsigned)ts_hi << 32) | (unsigned)ts_lo) : 0ull;
        if (lane == 62) stamps[62] = rt_entry; if (lane == 63) stamps[63] = (unsigned long long)wall_clock64(); }
#undef PG8_STAMP
#undef PG8_SA
#undef PG8_SB
#undef PG8_STAGE
#undef PG8_LDA
#undef PG8_LDB
#undef PG8_MMA
#undef PG8_WAIT_V
#undef PG8_WAIT_L
#undef PG8_BAR
#undef PG8_SCHED
}
}

#define LAS __attribute__((address_space(3)))
typedef unsigned short bf16_t;
typedef short s16x8 __attribute__((ext_vector_type(8)));
typedef short s16x4 __attribute__((ext_vector_type(4)));
typedef float f32x4 __attribute__((ext_vector_type(4)));
typedef unsigned u32x4 __attribute__((ext_vector_type(4)));
typedef unsigned u32x2 __attribute__((ext_vector_type(2)));

constexpr int DM = 2048, NB = 4, SEQ = 2048, NTOK = NB * SEQ, DFF = 5632, NHEAD = 16, HD = 128;
constexpr int NSA_LD = 5376, MOBA_LD = 6144, SWA_LD = 2560, MLA_DN_LD = 1280, MLA_Q_LD = 3072, MLA_KV_LD = 4096;
constexpr float ALPHA_F = 1.681792830507429f;
constexpr int LDS_BYTES = 131072 + 16;
constexpr int NJOBS = 26;

struct CvtJob { const float* src; bf16_t* dst; const float* kscale; int K, N, Npad, blk, stride, off, tile0; float wscale; };
struct Params {
    const float* x; const float* rel_bias; const float* swa_sinks; const float* cmp_pos; const float* cmp_w1;
    const float* q_norm; const float* kv_norm;
    const float* ln1_g; const float* ln1_b; const float* ln2_g; const float* ln2_b;
    float* out;
    const bf16_t* w_moba_qkv; const bf16_t* w_moba_o; const bf16_t* w_swa_qkv; const bf16_t* w_swa_o;
    const bf16_t* w_nsa_in; const bf16_t* w_nsa_o; const bf16_t* w_cmp1; const bf16_t* w_cmp2;
    const bf16_t* w_mla_down; const bf16_t* w_mla_uq; const bf16_t* w_mla_ukv; const bf16_t* w_mla_o;
    const bf16_t* w_gu; const bf16_t* w_dn;
    bf16_t* xb; _Float16* xh; float* y; bf16_t* proj; bf16_t* hid; bf16_t* att;
    float* kmean; bf16_t* pe_b16; float* rope; bf16_t* cmp_hid; bf16_t* kcvc; float* cdown; bf16_t* cqn; bf16_t* ckvn; bf16_t* krope; float* kr32; float* part;
    unsigned* bar; unsigned long long* stats; unsigned* pcnt;
    CvtJob jobs[NJOBS];
    int njobs, total_tiles;
};

typedef const __attribute__((address_space(4))) Params* KP;
__device__ __forceinline__ const Params& PK(KP kp) { asm volatile("" : "+s"(kp)); return *(const Params*)kp; }
__device__ __forceinline__ int ltid() { int t = threadIdx.x; asm volatile("" : "+v"(t)); return t; }
__device__ __forceinline__ float bf2f(bf16_t b) { return __uint_as_float(((unsigned)b) << 16); }
__device__ __forceinline__ bf16_t f2bf(float f) { unsigned u = __float_as_uint(f); u += 0x7FFFu + ((u >> 16) & 1u); return (bf16_t)(u >> 16); }
__device__ __forceinline__ unsigned pk2(float lo, float hi) { unsigned r; asm("v_cvt_pk_bf16_f32 %0, %1, %2" : "=v"(r) : "v"(lo), "v"(hi)); return r; }

__device__ __forceinline__ void phase0(const Params& p, LAS unsigned char* lds) {
    const int tid = ltid();
    for (int t = blockIdx.x; t < p.total_tiles; t += gridDim.x) {
        int ji = 0;
#pragma unroll 1
        for (int j = 1; j < p.njobs; ++j) if (t >= p.jobs[j].tile0) ji = j;
        const CvtJob jb = p.jobs[ji];
        const int lt = t - jb.tile0, ntn = jb.Npad >> 6, tk = lt / ntn, tn = lt % ntn;
        const int gn = tn * 64 + (tid & 63), k0 = tk * 512 + (tid >> 6) * 64;
        if (k0 >= jb.K) continue;
        float v[64];
        if (gn < jb.N) {
            const float* sp = jb.src + (size_t)k0 * jb.N + gn;
#pragma unroll
            for (int i = 0; i < 64; ++i) v[i] = __builtin_nontemporal_load(sp + (size_t)i * jb.N);
        } else {
#pragma unroll
            for (int i = 0; i < 64; ++i) v[i] = 0.f;
        }
        if (jb.kscale) {
#pragma unroll
            for (int i = 0; i < 64; ++i) v[i] *= jb.kscale[k0 + i];
        }
        if (jb.wscale != 1.0f) {
#pragma unroll
            for (int i = 0; i < 64; ++i) v[i] *= jb.wscale;
        }
        {
            const int row = (gn / jb.blk) * jb.stride + jb.off + (gn % jb.blk);
            bf16_t* dp = jb.dst + (size_t)row * jb.K + k0;
#pragma unroll
            for (int i = 0; i < 8; ++i) { u32x4 w; w.x = pk2(v[8 * i], v[8 * i + 1]); w.y = pk2(v[8 * i + 2], v[8 * i + 3]); w.z = pk2(v[8 * i + 4], v[8 * i + 5]); w.w = pk2(v[8 * i + 6], v[8 * i + 7]);
                *(u32x4*)(dp + 8 * i) = w; }
        }
    }
    {
        const size_t n8 = (size_t)NTOK * DM / 8;
        for (size_t i = (size_t)blockIdx.x * 512 + tid; i < n8; i += (size_t)gridDim.x * 512) {
            const f32x4 a = *(const f32x4*)(p.x + i * 8), b = *(const f32x4*)(p.x + i * 8 + 4);
            u32x4 w; w.x = pk2(a[0], a[1]); w.y = pk2(a[2], a[3]); w.z = pk2(b[0], b[1]); w.w = pk2(b[2], b[3]);
            *(u32x4*)(p.xb + i * 8) = w;
        }
    }
    for (int i = blockIdx.x * 512 + tid; i < SEQ * 32; i += gridDim.x * 512) {
        const int s = i >> 5, f = i & 31;
        const float inv = exp2f(-(float)(2 * f) * (13.287712379549449f / 64.0f));
        const float ang = (float)s * inv;
        const double a = (double)ang, k = rint(a * 0.15915494309189535);
        const float r = (float)(a - k * 6.283185307179586);
        p.rope[s * 64 + f] = __cosf(r); p.rope[s * 64 + 32 + f] = __sinf(r);
    }
    for (int i = blockIdx.x * 512 + tid; i < 2 * 4096; i += gridDim.x * 512) p.pe_b16[i] = f2bf(p.cmp_pos[i]);
}

__device__ __forceinline__ void ln_phase(const float* y, const float* g, const float* b, float* xf, bf16_t* xb) {
    const int tid = ltid(), lane = tid & 63, wave = tid >> 6;
    for (int row = blockIdx.x * 8 + wave; row < NTOK; row += gridDim.x * 8) {
        const float* yr = y + (size_t)row * DM;
        f32x4 v[8]; float s = 0.f;
#pragma unroll
        for (int i = 0; i < 8; ++i) { v[i] = *(const f32x4*)(yr + i * 256 + lane * 4); s += (v[i][0] + v[i][1]) + (v[i][2] + v[i][3]); }
#pragma unroll
        for (int o = 32; o > 0; o >>= 1) s += __shfl_xor(s, o);
        const float mean = s * (1.0f / DM); float q = 0.f;
#pragma unroll
        for (int i = 0; i < 8; ++i) { const f32x4 d = v[i] - mean; q += (d[0] * d[0] + d[1] * d[1]) + (d[2] * d[2] + d[3] * d[3]); }
#pragma unroll
        for (int o = 32; o > 0; o >>= 1) q += __shfl_xor(q, o);
        const float rstd = rsqrtf(q * (1.0f / DM) + 1e-5f);
#pragma unroll
        for (int i = 0; i < 8; ++i) {
            const int c = i * 256 + lane * 4;
            const f32x4 gg = *(const f32x4*)(g + c), bb = *(const f32x4*)(b + c);
            const f32x4 o = (v[i] - mean) * rstd * gg + bb;
            *(f32x4*)(xf + (size_t)row * DM + c) = o;
            if (xb) { u32x2 w; w.x = pk2(o[0], o[1]); w.y = pk2(o[2], o[3]); *(u32x2*)(xb + (size_t)row * DM + c) = w; }
        }
    }
}

constexpr int A_KB0 = 0, A_KBSZ = 25600, A_VB0 = 51200, A_VBSZ = 18432, A_LUT = 106496, A_LUTS = 132, A_RMASK = 110720, A_UMASK = 111744, A_IMP = 111872, A_IMPF = 120064;
constexpr int VSTR = 288;
constexpr float NEG_BIG = -1e30f;

__device__ __forceinline__ s16x4 vtr(const LAS unsigned char* pp) {
    typedef short v4i16_t __attribute__((ext_vector_type(4)));
    return __builtin_bit_cast(s16x4, __builtin_amdgcn_ds_read_tr16_b64_v4i16((LAS v4i16_t*)pp));
}

__device__ __forceinline__ int t5_bucket_dev(int n) {
    if (n < 16) return n;
    const float nf = (float)n;
    int large = 16 + (int)(logf(nf / 16.0f) / 2.0794415416798357f * 16.0f);
    return large < 31 ? large : 31;
}
__device__ __forceinline__ void build_lut(LAS unsigned char* lds, const float* rel_bias, int h0, int G) {
    LAS float* L = (LAS float*)(lds + A_LUT);
    for (int i = ltid(); i < G * 129; i += 512) { const int g = i / 129, d = i % 129; L[g * A_LUTS + d] = rel_bias[t5_bucket_dev(d) * NHEAD + h0 + g] * 1.4426950408889634f; }
}

template <int DQK>
struct KVSrc { const bf16_t* K; size_t ldk; const bf16_t* K2; size_t ldk2; const bf16_t* V; size_t ldv; int nk; };

template <int DQK>
struct KVPlan { const char* kp; const char* vp; const char* rp; unsigned kstep, vstep, rstep, klo, vlo, rlo; };
template <>
struct KVPlan<128> { const char* kp; const char* vp; unsigned kstep, vstep, klo, vlo; };
__device__ __forceinline__ void kv_plan(const KVSrc<128>& s, KVPlan<128>& pl) {
    const int tid = ltid(), row = tid >> 4, ch = tid & 15;
    pl.kp = (const char*)(s.K + (size_t)row * s.ldk + ch * 8); pl.vp = (const char*)(s.V + (size_t)row * s.ldv + ch * 8);
    pl.kstep = (unsigned)(s.ldk * 64); pl.vstep = (unsigned)(s.ldv * 64);
    pl.klo = (unsigned)(row * 272 + ch * 16); pl.vlo = (unsigned)(row * VSTR + ch * 16);
}
__device__ __forceinline__ void kv_gload(const KVPlan<128>& pl, int jt, u32x4 (&kr)[2], u32x4 (&vr)[2]) {
#pragma unroll
    for (int i = 0; i < 2; ++i) { kr[i] = *(const u32x4*)(pl.kp + (size_t)(2 * jt + i) * pl.kstep); vr[i] = *(const u32x4*)(pl.vp + (size_t)(2 * jt + i) * pl.vstep); }
}
__device__ __forceinline__ void kv_lstore(LAS unsigned char* lds, int kbuf, int vbuf, const KVPlan<128>& pl, const u32x4 (&kr)[2], const u32x4 (&vr)[2]) {
#pragma unroll
    for (int i = 0; i < 2; ++i) { *(LAS u32x4*)(lds + A_KB0 + kbuf * A_KBSZ + pl.klo + i * 32 * 272) = kr[i]; *(LAS u32x4*)(lds + A_VB0 + vbuf * A_VBSZ + pl.vlo + i * 32 * VSTR) = vr[i]; }
}
__device__ __forceinline__ void kv_plan(const KVSrc<192>& s, KVPlan<192>& pl) {
    const int tid = ltid(), row = tid >> 4, ch = tid & 15, rrow = tid >> 3, rch = tid & 7;
    pl.kp = (const char*)(s.K + (size_t)row * s.ldk + ch * 8); pl.vp = (const char*)(s.V + (size_t)row * s.ldv + ch * 8);
    pl.rp = (const char*)(s.K2 + (size_t)rrow * s.ldk2 + rch * 8);
    pl.kstep = (unsigned)(s.ldk * 64); pl.vstep = (unsigned)(s.ldv * 64); pl.rstep = (unsigned)(s.ldk2 * 128);
    pl.klo = (unsigned)(row * 400 + ch * 16); pl.vlo = (unsigned)(row * VSTR + ch * 16); pl.rlo = (unsigned)(rrow * 400 + 256 + rch * 16);
}
__device__ __forceinline__ void kv_gload(const KVPlan<192>& pl, int jt, u32x4 (&kr)[3], u32x4 (&vr)[2]) {
#pragma unroll
    for (int i = 0; i < 2; ++i) { kr[i] = *(const u32x4*)(pl.kp + (size_t)(2 * jt + i) * pl.kstep); vr[i] = *(const u32x4*)(pl.vp + (size_t)(2 * jt + i) * pl.vstep); }
    kr[2] = *(const u32x4*)(pl.rp + (size_t)jt * pl.rstep);
}
__device__ __forceinline__ void kv_lstore(LAS unsigned char* lds, int kbuf, int vbuf, const KVPlan<192>& pl, const u32x4 (&kr)[3], const u32x4 (&vr)[2]) {
#pragma unroll
    for (int i = 0; i < 2; ++i) { *(LAS u32x4*)(lds + A_KB0 + kbuf * A_KBSZ + pl.klo + i * 32 * 400) = kr[i]; *(LAS u32x4*)(lds + A_VB0 + vbuf * A_VBSZ + pl.vlo + i * 32 * VSTR) = vr[i]; }
    *(LAS u32x4*)(lds + A_KB0 + kbuf * A_KBSZ + pl.rlo) = kr[2];
}

struct MaskCfg { int KS, KO, W, bsh, nk; float scale; };

__device__ __forceinline__ float rmax16(float x) { auto r = __builtin_amdgcn_permlane16_swap(__float_as_uint(x), __float_as_uint(x), false, false); return fmaxf(__uint_as_float(r[0]), __uint_as_float(r[1])); }
__device__ __forceinline__ float rmax32(float x) { auto r = __builtin_amdgcn_permlane32_swap(__float_as_uint(x), __float_as_uint(x), false, false); return fmaxf(__uint_as_float(r[0]), __uint_as_float(r[1])); }
__device__ __forceinline__ float rsum16(float x) { auto r = __builtin_amdgcn_permlane16_swap(__float_as_uint(x), __float_as_uint(x), false, false); return __uint_as_float(r[0]) + __uint_as_float(r[1]); }
__device__ __forceinline__ float rsum32(float x) { auto r = __builtin_amdgcn_permlane32_swap(__float_as_uint(x), __float_as_uint(x), false, false); return __uint_as_float(r[0]) + __uint_as_float(r[1]); }
__device__ __forceinline__ int wave_min_i(int v) {
#pragma unroll
    for (int o = 1; o < 64; o <<= 1) { const int t = __shfl_xor(v, o); v = t < v ? t : v; }
    return __builtin_amdgcn_readfirstlane(v);
}
__device__ __forceinline__ int wave_max_i(int v) {
#pragma unroll
    for (int o = 1; o < 64; o <<= 1) { const int t = __shfl_xor(v, o); v = t > v ? t : v; }
    return __builtin_amdgcn_readfirstlane(v);
}

template <int DQK, int QT, bool BIAS>
__device__ __forceinline__ void qk_tile(LAS unsigned char* lds, int buf, int jt, const s16x8 (&Qf)[QT][DQK / 32], f32x4 (&S)[4][QT],
                                        const MaskCfg& mc, const int (&qpos)[QT], const unsigned (&rmask)[QT], int gl, int qlo_w, int qhi_w, const float (&mref)[QT]) {
    constexpr int KSTR = DQK * 2 + 16;
    const int lane = ltid() & 63, fr = lane & 15, g4 = lane >> 4;
    const LAS unsigned char* kb = lds + A_KB0 + buf * A_KBSZ + fr * KSTR + g4 * 16;
    {
        constexpr int NKS = DQK / 32, NF = 4 * NKS;
        __builtin_amdgcn_s_setprio(1);
        s16x8 kf[3];
        kf[0] = *(const LAS s16x8*)(kb);
        kf[1] = *(const LAS s16x8*)(kb + 64);
#pragma unroll
        for (int f = 0; f < NF; ++f) {
            const int kt = f / NKS, ks = f % NKS;
            if (f + 2 < NF) { const int kt2 = (f + 2) / NKS, ks2 = (f + 2) % NKS; kf[(f + 2) % 3] = *(const LAS s16x8*)(kb + kt2 * 16 * KSTR + ks2 * 64); }
            if (ks == 0) {
#pragma unroll
                for (int qt = 0; qt < QT; ++qt) S[kt][qt] = (f32x4){0.f, 0.f, 0.f, 0.f};
            }
#pragma unroll
            for (int qt = 0; qt < QT; ++qt) S[kt][qt] = __builtin_amdgcn_mfma_f32_16x16x32_bf16(kf[f % 3], Qf[qt][ks], S[kt][qt], 0, 0, 0);
        }
        __builtin_amdgcn_sched_group_barrier(0x100, 2, 0);
#pragma unroll
        for (int f = 0; f < NF; ++f) {
            if (f + 2 < NF) __builtin_amdgcn_sched_group_barrier(0x100, 1, 0);
            __builtin_amdgcn_sched_group_barrier(0x008, QT, 0);
        }
        __builtin_amdgcn_s_setprio(0);
    }
    const LAS float* L = (const LAS float*)(lds + A_LUT);
    const int kmin = jt * 64 * mc.KS + mc.KO, kmax = (jt * 64 + 63) * mc.KS + mc.KO;
    const bool slow = (kmax > qlo_w) || (qhi_w - kmin >= mc.W) || (jt * 64 + 63 >= mc.nk) || (BIAS && (qlo_w - kmax < 128));
    if (!slow) {
#pragma unroll
        for (int qt = 0; qt < QT; ++qt) {
            const bool rowok = (rmask[qt] >> ((jt * 64) >> mc.bsh)) & 1u;
            const float a = rowok ? mc.scale : 0.f;
            float c = rowok ? -mref[qt] : NEG_BIG;
            if (BIAS) c = rowok ? L[gl * A_LUTS + 128] - mref[qt] : NEG_BIG;
#pragma unroll
            for (int kt = 0; kt < 4; ++kt)
#pragma unroll
                for (int i = 0; i < 4; ++i) S[kt][qt][i] = __builtin_fmaf(S[kt][qt][i], a, c);
        }
    } else {
        const int j0 = jt * 64 + g4 * 4;
#pragma unroll
        for (int qt = 0; qt < QT; ++qt) {
            const int d0 = qpos[qt] - (j0 * mc.KS + mc.KO);
#pragma unroll
            for (int kt = 0; kt < 4; ++kt) {
                float bv[4];
#pragma unroll
                for (int i = 0; i < 4; ++i) {
                    const int dist = d0 - (kt * 16 + i) * mc.KS;
                    const int dd = dist < 0 ? 0 : (dist > 128 ? 128 : dist);
                    bv[i] = BIAS ? L[gl * A_LUTS + dd] : 0.f;
                }
#pragma unroll
                for (int i = 0; i < 4; ++i) {
                    const int j = j0 + kt * 16 + i;
                    const int dist = d0 - (kt * 16 + i) * mc.KS;
                    const unsigned ok = (unsigned)(dist >= 0) & (unsigned)(dist < mc.W) & (unsigned)(j < mc.nk) & ((rmask[qt] >> (j >> mc.bsh)) & 1u);
                    const float s = __builtin_fmaf(S[kt][qt][i], mc.scale, bv[i] - mref[qt]);
                    S[kt][qt][i] = ok ? s : NEG_BIG;
                }
            }
        }
    }
}

template <int QT>
__device__ __forceinline__ void pv_tile(LAS unsigned char* lds, int vbuf, const s16x8 (&Pf)[2][QT], f32x4 (&O)[8][QT]) {
    const int lane = ltid() & 63, g4 = lane >> 4, q4 = (lane & 15) >> 2, p4 = lane & 3;
    const LAS unsigned char* vb = lds + A_VB0 + vbuf * A_VBSZ + (4 * g4 + q4) * VSTR + p4 * 8;
    __builtin_amdgcn_s_setprio(1);
    s16x4 va[3], vb2[3];
    va[0] = vtr(vb); vb2[0] = vtr(vb + 16 * VSTR);
    va[1] = vtr(vb + 32); vb2[1] = vtr(vb + 16 * VSTR + 32);
#pragma unroll
    for (int f = 0; f < 16; ++f) {
        const int kk = f >> 3, dt = f & 7;
        if (f + 2 < 16) { const int kk2 = (f + 2) >> 3, dt2 = (f + 2) & 7; va[(f + 2) % 3] = vtr(vb + (kk2 * 32) * VSTR + dt2 * 32); vb2[(f + 2) % 3] = vtr(vb + (kk2 * 32 + 16) * VSTR + dt2 * 32); }
        const s16x4 v0 = va[f % 3], v1 = vb2[f % 3];
        const s16x8 vf = (s16x8){v0[0], v0[1], v0[2], v0[3], v1[0], v1[1], v1[2], v1[3]};
#pragma unroll
        for (int qt = 0; qt < QT; ++qt) O[dt][qt] = __builtin_amdgcn_mfma_f32_16x16x32_bf16(vf, Pf[kk][qt], O[dt][qt], 0, 0, 0);
    }
    __builtin_amdgcn_sched_group_barrier(0x100, 4, 1);
#pragma unroll
    for (int f = 0; f < 16; ++f) {
        if (f + 2 < 16) __builtin_amdgcn_sched_group_barrier(0x100, 2, 1);
        __builtin_amdgcn_sched_group_barrier(0x008, QT, 1);
    }
    __builtin_amdgcn_s_setprio(0);
}

template <int DQK, int QT, bool BIAS, bool LAG = true>
__device__ __forceinline__ void attn_pass(LAS unsigned char* lds, const KVSrc<DQK>& src, unsigned long long act, const MaskCfg& mc,
                                          const s16x8 (&Qf)[QT][DQK / 32], f32x4 (&O)[8][QT], float (&m)[QT], float (&l)[QT],
                                          const int (&qpos)[QT], const unsigned (&rmask)[QT], int gl) {
    const int tidv = ltid(), lane = tidv & 63, g4 = lane >> 4;
    const bool lag = LAG && (__builtin_amdgcn_readfirstlane(tidv >> 8) != 0);
    if (act == 0ull) return;
    int qlo_w, qhi_w;
    { int a = qpos[0], b = qpos[0];
#pragma unroll
      for (int qt = 1; qt < QT; ++qt) { a = qpos[qt] < a ? qpos[qt] : a; b = qpos[qt] > b ? qpos[qt] : b; }
      qlo_w = wave_min_i(a); qhi_w = wave_max_i(b); }
    u32x4 kr[DQK / 64], vr[2];
    KVPlan<DQK> pl; kv_plan(src, pl);
    int jt = __builtin_ctzll(act); act &= act - 1ull;
    kv_gload(pl, jt, kr, vr);
    __syncthreads();
    kv_lstore(lds, 0, 0, pl, kr, vr);
    __syncthreads();
    int kbuf = 0, vbuf = 0;
    float lp[QT];
#pragma unroll
    for (int qt = 0; qt < QT; ++qt) lp[qt] = (g4 == 0) ? l[qt] : 0.f;
    s16x8 Pf[2][QT];
    bool havep = false;
    for (;;) {
        const bool has_next = (act != 0ull);
        int jn = 0;
        if (has_next) { jn = __builtin_ctzll(act); act &= act - 1ull; kv_gload(pl, jn, kr, vr); }
        if (lag && havep) { pv_tile<QT>(lds, vbuf == 0 ? 2 : vbuf - 1, Pf, O); havep = false; }
        const bool skip = ((jt * 64) * mc.KS + mc.KO > qhi_w) || (qlo_w - ((jt * 64 + 63) * mc.KS + mc.KO) >= mc.W);
        if (!skip) {
        f32x4 S[4][QT];
        float mref[QT];
#pragma unroll
        for (int qt = 0; qt < QT; ++qt) mref[qt] = (m[qt] < -1e29f) ? 0.f : m[qt];
        qk_tile<DQK, QT, BIAS>(lds, kbuf, jt, Qf, S, mc, qpos, rmask, gl, qlo_w, qhi_w, mref);
#pragma unroll
        for (int qt = 0; qt < QT; ++qt) {
            float mx = NEG_BIG;
#pragma unroll
            for (int kt = 0; kt < 4; ++kt)
#pragma unroll
                for (int i = 0; i < 4; ++i) mx = fmaxf(mx, S[kt][qt][i]);
            mx = rmax16(mx); mx = rmax32(mx);
            const float mold_rel = (m[qt] < -1e29f) ? NEG_BIG : 0.f;
            const float mnew_rel = fmaxf(mold_rel, mx);
            const float muse = (mnew_rel < -1e29f) ? 0.f : mnew_rel;
            const bool grow = (mold_rel < -1e29f) ? (mx > -1e29f) : (mx > 10.0f);
            if (__any(grow)) {
                const float alpha = __builtin_amdgcn_exp2f(mold_rel - mnew_rel);
#pragma unroll
                for (int kt = 0; kt < 4; ++kt)
#pragma unroll
                    for (int i = 0; i < 4; ++i) S[kt][qt][i] = __builtin_amdgcn_exp2f(S[kt][qt][i] - muse);
#pragma unroll
                for (int dt = 0; dt < 8; ++dt) O[dt][qt] *= alpha;
                lp[qt] *= alpha;
                m[qt] = mnew_rel + mref[qt];
            } else {
#pragma unroll
                for (int kt = 0; kt < 4; ++kt)
#pragma unroll
                    for (int i = 0; i < 4; ++i) S[kt][qt][i] = __builtin_amdgcn_exp2f(S[kt][qt][i]);
            }
            { f32x4 sv = (S[0][qt] + S[1][qt]) + (S[2][qt] + S[3][qt]); lp[qt] += (sv[0] + sv[1]) + (sv[2] + sv[3]); }
#pragma unroll
            for (int kk = 0; kk < 2; ++kk) {
                u32x4 w; w.x = pk2(S[2 * kk][qt][0], S[2 * kk][qt][1]); w.y = pk2(S[2 * kk][qt][2], S[2 * kk][qt][3]);
                w.z = pk2(S[2 * kk + 1][qt][0], S[2 * kk + 1][qt][1]); w.w = pk2(S[2 * kk + 1][qt][2], S[2 * kk + 1][qt][3]);
                Pf[kk][qt] = __builtin_bit_cast(s16x8, w);
            }
        }
        havep = true;
        if (!lag) pv_tile<QT>(lds, vbuf, Pf, O);
        }
        if (!has_next) break;
        const int vnext = vbuf == 2 ? 0 : vbuf + 1;
        kv_lstore(lds, kbuf ^ 1, vnext, pl, kr, vr);
        __syncthreads();
        kbuf ^= 1; vbuf = vnext; jt = jn;
    }
    if (lag && havep) pv_tile<QT>(lds, vbuf, Pf, O);
#pragma unroll
    for (int qt = 0; qt < QT; ++qt) l[qt] = rsum32(rsum16(lp[qt]));
}

template <int QT>
__device__ __forceinline__ void attn_init(f32x4 (&O)[8][QT], float (&m)[QT], float (&l)[QT]) {
#pragma unroll
    for (int qt = 0; qt < QT; ++qt) { m[qt] = NEG_BIG; l[qt] = 0.f;
#pragma unroll
        for (int dt = 0; dt < 8; ++dt) O[dt][qt] = (f32x4){0.f, 0.f, 0.f, 0.f}; }
}
template <int QT>
__device__ __forceinline__ void attn_store(const f32x4 (&O)[8][QT], const float (&l)[QT], bf16_t* const (&orow)[QT]) {
    const int g4 = (ltid() & 63) >> 4;
#pragma unroll
    for (int qt = 0; qt < QT; ++qt) { const float inv = 1.0f / fmaxf(l[qt], 1e-30f);
#pragma unroll
        for (int dt = 0; dt < 8; ++dt) { const f32x4 o = O[dt][qt] * inv; u32x2 w; w.x = pk2(o[0], o[1]); w.y = pk2(o[2], o[3]); *(u32x2*)(orow[qt] + dt * 16 + 4 * g4) = w; } }
}
__device__ __forceinline__ int qc_order(int t, int per, int nq) { const int r = t / per; const int q = r % nq; return (r / nq) * 0 + ((r & 1) ? q : (nq - 1 - q)); }

__device__ __forceinline__ void moba_kmean_phase(const Params& p, LAS unsigned char* lds) {
    const int tid = ltid(); LAS float* R = (LAS float*)lds;
    for (int job = blockIdx.x; job < NB * NHEAD * 8; job += gridDim.x) {
        const int blk = job & 7, h = (job >> 3) & 15, b = job >> 7;
        const int d8 = (tid & 15) * 8, jg = tid >> 4;
        float acc[8];
#pragma unroll
        for (int e = 0; e < 8; ++e) acc[e] = 0.f;
#pragma unroll
        for (int i = 0; i < 8; ++i) {
            const int j = jg + 32 * i;
            const s16x8 v = *(const s16x8*)(p.proj + (size_t)(b * SEQ + blk * 256 + j) * MOBA_LD + 2048 + h * HD + d8);
#pragma unroll
            for (int e = 0; e < 8; ++e) acc[e] += bf2f((bf16_t)v[e]);
        }
        __syncthreads();
#pragma unroll
        for (int e = 0; e < 8; ++e) R[jg * 128 + d8 + e] = acc[e];
        __syncthreads();
        if (tid < 128) { float s = 0.f; for (int g = 0; g < 32; ++g) s += R[g * 128 + tid]; p.kmean[(size_t)job * 128 + tid] = s * (1.0f / 256.0f); }
    }
    __syncthreads();
}

__device__ __forceinline__ void moba_attn_phase(const Params& p, LAS unsigned char* lds) {
    const int tid = ltid(), lane = tid & 63, wave = tid >> 6, fr = lane & 15, g4 = lane >> 4;
    LAS unsigned* RM = (LAS unsigned*)(lds + A_RMASK); LAS unsigned* UM = (LAS unsigned*)(lds + A_UMASK);
    for (int t = blockIdx.x; t < NB * NHEAD * 8; t += gridDim.x) {
        const int per = NB * NHEAD, n = (t / per) < 4 ? (7 - t / per) : (t / per - 4), bh = t % per, b = bh >> 4, h = bh & 15;
        __syncthreads();
        build_lut(lds, p.rel_bias, h, 1);
        if (tid == 0) UM[0] = 0u;
        __syncthreads();
        if (tid < 256) {
            unsigned mask = 1u << n;
            if (n <= 3) mask |= (1u << n) - 1u;
            else {
                const bf16_t* qr = p.proj + (size_t)(b * SEQ + n * 256 + tid) * MOBA_LD + h * HD;
                float g0 = 0.f, g1 = 0.f, g2 = 0.f, g3 = 0.f, g5 = 0.f, g6 = 0.f, g7 = 0.f;
                float gate[7];
#pragma unroll
                for (int j = 0; j < 7; ++j) gate[j] = 0.f;
                const float* km = p.kmean + (size_t)(b * NHEAD + h) * 8 * 128;
                for (int d8 = 0; d8 < 128; d8 += 8) {
                    const s16x8 qv = *(const s16x8*)(qr + d8);
#pragma unroll
                    for (int j = 0; j < 7; ++j) if (j < n) {
                        const f32x4 k0 = *(const f32x4*)(km + j * 128 + d8), k1 = *(const f32x4*)(km + j * 128 + d8 + 4);
#pragma unroll
                        for (int e = 0; e < 4; ++e) gate[j] += bf2f((bf16_t)qv[e]) * k0[e] + bf2f((bf16_t)qv[4 + e]) * k1[e];
                    }
                }
                (void)g0; (void)g1; (void)g2; (void)g3; (void)g5; (void)g6; (void)g7;
                unsigned picked = 0u;
#pragma unroll
                for (int r = 0; r < 3; ++r) {
                    float best = -3e38f; int bi = 0;
#pragma unroll
                    for (int j = 0; j < 7; ++j) if (j < n && !((picked >> j) & 1u) && gate[j] > best) { best = gate[j]; bi = j; }
                    picked |= 1u << bi;
                }
                mask |= picked;
            }
            RM[tid] = mask; atomicOr((unsigned*)UM, mask);
        }
        __syncthreads();
        const unsigned um = UM[0];
        unsigned long long act = 0ull;
        for (int j = 0; j <= n; ++j) if ((um >> j) & 1u) act |= 0xFull << (4 * j);
        int qpos[2]; unsigned rmask[2]; int gl = 0; s16x8 Qf[2][4]; bf16_t* orow[2];
#pragma unroll
        for (int qt = 0; qt < 2; ++qt) {
            const int r = wave * 32 + qt * 16 + fr; qpos[qt] = n * 256 + r; rmask[qt] = RM[r];
            const bf16_t* qr = p.proj + (size_t)(b * SEQ + qpos[qt]) * MOBA_LD + h * HD + g4 * 8;
#pragma unroll
            for (int ks = 0; ks < 4; ++ks) Qf[qt][ks] = *(const s16x8*)(qr + ks * 32);
            orow[qt] = p.att + (size_t)(b * SEQ + qpos[qt]) * DM + h * HD;
        }
        KVSrc<128> src{p.proj + (size_t)b * SEQ * MOBA_LD + 2048 + h * HD, (size_t)MOBA_LD, nullptr, 0, p.proj + (size_t)b * SEQ * MOBA_LD + 4096 + h * HD, (size_t)MOBA_LD, SEQ};
        MaskCfg mc{1, 0, 1 << 30, 8, SEQ, 0.08838834764831845f * 1.4426950408889634f};
        f32x4 O[8][2]; float m[2], l[2];
        attn_init<2>(O, m, l);
        attn_pass<128, 2, true>(lds, src, act, mc, Qf, O, m, l, qpos, rmask, gl);
        attn_store<2>(O, l, orow);
    }
    __syncthreads();
}

__device__ __forceinline__ void swa_attn_phase(const Params& p, LAS unsigned char* lds) {
    const int tid = ltid(), lane = tid & 63, wave = tid >> 6, fr = lane & 15, g4 = lane >> 4;
    for (int t = blockIdx.x; t < NB * 2 * 64; t += gridDim.x) {
        const int qc = t >> 3, bk = t & 7, b = bk >> 1, hk = bk & 1, q0 = qc * 32;
        __syncthreads();
        build_lut(lds, p.rel_bias, hk * 8, 8);
        __syncthreads();
        int qpos[2]; unsigned rmask[2]; int gl = 0; s16x8 Qf[2][4]; bf16_t* orow[2];
        const int head = hk * 8 + wave;
#pragma unroll
        for (int qt = 0; qt < 2; ++qt) {
            qpos[qt] = q0 + qt * 16 + fr; rmask[qt] = 0xFFFFFFFFu; gl = __builtin_amdgcn_readfirstlane(wave);
            const bf16_t* qr = p.proj + (size_t)(b * SEQ + qpos[qt]) * SWA_LD + head * HD + g4 * 8;
#pragma unroll
            for (int ks = 0; ks < 4; ++ks) Qf[qt][ks] = *(const s16x8*)(qr + ks * 32);
            orow[qt] = p.att + (size_t)(b * SEQ + qpos[qt]) * DM + head * HD;
        }
        KVSrc<128> src{p.proj + (size_t)b * SEQ * SWA_LD + 2048 + hk * HD, (size_t)SWA_LD, nullptr, 0, p.proj + (size_t)b * SEQ * SWA_LD + 2304 + hk * HD, (size_t)SWA_LD, SEQ};
        MaskCfg mc{1, 0, 128, 31, SEQ, 0.08838834764831845f * 1.4426950408889634f};
        const int tlo = (q0 - 127 < 0 ? 0 : q0 - 127) >> 6, thi = (q0 + 31) >> 6;
        unsigned long long act = 0ull;
        for (int j = tlo; j <= thi; ++j) act |= 1ull << j;
        f32x4 O[8][2]; float m[2], l[2];
        attn_init<2>(O, m, l);
        const float sink = p.swa_sinks[head] * 1.4426950408889634f;
        m[0] = sink; m[1] = sink; l[0] = 1.f; l[1] = 1.f;
        attn_pass<128, 2, true>(lds, src, act, mc, Qf, O, m, l, qpos, rmask, gl);
        attn_store<2>(O, l, orow);
    }
    __syncthreads();
}

__device__ __forceinline__ void mla_norm_phase(const Params& p) {
    const int tid = ltid(), lane = tid & 63, wave = tid >> 6;
    for (int row = blockIdx.x * 8 + wave; row < NTOK; row += gridDim.x * 8) {
        const float* cr = p.cdown + (size_t)row * MLA_DN_LD;
#pragma unroll
        for (int part = 0; part < 2; ++part) {
            f32x4 v[2]; float s = 0.f;
#pragma unroll
            for (int i = 0; i < 2; ++i) { v[i] = *(const f32x4*)(cr + part * 512 + i * 256 + lane * 4); s += (v[i][0] * v[i][0] + v[i][1] * v[i][1]) + (v[i][2] * v[i][2] + v[i][3] * v[i][3]); }
#pragma unroll
            for (int o = 32; o > 0; o >>= 1) s += __shfl_xor(s, o);
            const float r = rsqrtf(s * (1.0f / 512.0f) + 1e-6f);
            const float* gw = part ? p.kv_norm : p.q_norm; bf16_t* dst = (part ? p.ckvn : p.cqn) + (size_t)row * 512;
#pragma unroll
            for (int i = 0; i < 2; ++i) { const int c = i * 256 + lane * 4; const f32x4 gg = *(const f32x4*)(gw + c); const f32x4 o = v[i] * r * gg;
                u32x2 w; w.x = pk2(o[0], o[1]); w.y = pk2(o[2], o[3]); *(u32x2*)(dst + c) = w; }
        }
        if (lane < 32) {
            const int s = row % SEQ; const float t1 = cr[1024 + lane], t2 = cr[1024 + 32 + lane];
            const float c = p.rope[s * 64 + lane], sn = p.rope[s * 64 + 32 + lane];
            p.krope[(size_t)row * 64 + lane] = f2bf(t1 * c - t2 * sn); p.krope[(size_t)row * 64 + 32 + lane] = f2bf(t1 * sn + t2 * c);
        }
    }
}

__device__ __forceinline__ void mla_attn_phase(const Params& p, LAS unsigned char* lds) {
    const int tid = ltid(), lane = tid & 63, wave = tid >> 6, fr = lane & 15, g4 = lane >> 4;
    for (int t = blockIdx.x; t < NB * NHEAD * 8; t += gridDim.x) {
        const int per = NB * NHEAD, n = (t / per) < 4 ? (7 - t / per) : (t / per - 4), bh = t % per, b = bh >> 4, h = bh & 15;
        int qpos[2]; unsigned rmask[2]; int gl = 0; s16x8 Qf[2][6]; bf16_t* orow[2];
#pragma unroll
        for (int qt = 0; qt < 2; ++qt) {
            const int r = wave * 32 + qt * 16 + fr; qpos[qt] = n * 256 + r; rmask[qt] = 0xFFFFFFFFu;
            const bf16_t* qr = p.proj + (size_t)(b * SEQ + qpos[qt]) * MLA_Q_LD + h * 192 + g4 * 8;
#pragma unroll
            for (int ks = 0; ks < 6; ++ks) Qf[qt][ks] = *(const s16x8*)(qr + ks * 32);
            const float* rp = p.rope + qpos[qt] * 64 + g4 * 8;
            s16x8 a = Qf[qt][4], c2 = Qf[qt][5];
#pragma unroll
            for (int e = 0; e < 8; ++e) { const float t1 = bf2f((bf16_t)a[e]), t2 = bf2f((bf16_t)c2[e]), cs = rp[e], sn = rp[32 + e];
                a[e] = (short)f2bf(t1 * cs - t2 * sn); c2[e] = (short)f2bf(t1 * sn + t2 * cs); }
            Qf[qt][4] = a; Qf[qt][5] = c2;
            orow[qt] = p.att + (size_t)(b * SEQ + qpos[qt]) * DM + h * HD;
        }
        const bf16_t* kvb = p.proj + (size_t)NTOK * MLA_Q_LD + (size_t)b * SEQ * MLA_KV_LD + h * 256;
        KVSrc<192> src{kvb, (size_t)MLA_KV_LD, p.krope + (size_t)b * SEQ * 64, 64, kvb + 128, (size_t)MLA_KV_LD, SEQ};
        MaskCfg mc{1, 0, 1 << 30, 31, SEQ, 0.07216878364870322f * 1.4426950408889634f};
        unsigned long long act = 0ull;
        for (int j = 0; j < 4 * (n + 1); ++j) act |= 1ull << j;
        f32x4 O[8][2]; float m[2], l[2];
        attn_init<2>(O, m, l);
        attn_pass<192, 2, false, false>(lds, src, act, mc, Qf, O, m, l, qpos, rmask, gl);
        attn_store<2>(O, l, orow);
    }
    __syncthreads();
}

__device__ __forceinline__ float gelu_tanh(float x) { const float u = 0.7978845608028654f * (x + 0.044715f * x * x * x); const float e = __expf(2.0f * u); const float th = 1.0f - 2.0f * __builtin_amdgcn_rcpf(e + 1.0f); return 0.5f * x * (1.0f + th); }

__device__ __forceinline__ void nsa_cmp1_phase(const Params& p, LAS unsigned char* lds) {
    const int tid = ltid(), lane = tid & 63, wave = tid >> 6, fr = lane & 15, g4 = lane >> 4;
    for (int t = blockIdx.x; t < 256; t += gridDim.x) {
        const int nq = t & 7, bk = (t >> 3) & 15, kv = t >> 7, b = bk >> 2, hk = bk & 3;
        const int c = wave * 16 + fr;
        const bf16_t* arow = (c < 127) ? p.proj + (size_t)(b * SEQ + c * 16) * NSA_LD + 2048 + kv * 512 + hk * HD + g4 * 8 : p.pe_b16 + kv * 4096 + g4 * 8;
        const size_t lstr = (c < 127) ? (size_t)NSA_LD : (size_t)128;
        const bf16_t* brow = p.w_cmp1 + (size_t)kv * 256 * 4096 + (size_t)(nq * 32 + fr) * 4096 + g4 * 8;
        f32x4 acc[2];
#pragma unroll
        for (int i = 0; i < 2; ++i) acc[i] = (f32x4){0.f, 0.f, 0.f, 0.f};
#pragma unroll 1
        for (int l8 = 0; l8 < 32; l8 += 2) {
            s16x8 af[8], bf[8][2];
#pragma unroll
            for (int u = 0; u < 8; ++u) { const int ks = l8 * 4 + u;
                af[u] = *(const s16x8*)(arow + (size_t)(ks >> 2) * lstr + (ks & 3) * 32);
                bf[u][0] = *(const s16x8*)(brow + ks * 32); bf[u][1] = *(const s16x8*)(brow + (size_t)16 * 4096 + ks * 32); }
#pragma unroll
            for (int u = 0; u < 8; ++u) { acc[0] = __builtin_amdgcn_mfma_f32_16x16x32_bf16(bf[u][0], af[u], acc[0], 0, 0, 0); acc[1] = __builtin_amdgcn_mfma_f32_16x16x32_bf16(bf[u][1], af[u], acc[1], 0, 0, 0); }
        }
        LAS float* PB = (LAS float*)lds;
        __syncthreads();
        if (c == 127) {
#pragma unroll
            for (int nt = 0; nt < 2; ++nt) *(LAS f32x4*)(PB + nt * 16 + 4 * g4) = acc[nt];
        }
        __syncthreads();
        bf16_t* orow = p.cmp_hid + ((size_t)(kv * 16 + bk) * 128 + c) * 256 + nq * 32;
#pragma unroll
        for (int nt = 0; nt < 2; ++nt) { const int n0 = nt * 16 + 4 * g4; const f32x4 pb = *(const LAS f32x4*)(PB + n0);
            const f32x4 v = acc[nt] + pb; u32x2 w; w.x = pk2(gelu_tanh(v[0]), gelu_tanh(v[1])); w.y = pk2(gelu_tanh(v[2]), gelu_tanh(v[3])); *(u32x2*)(orow + n0) = w; }
    }
}
__device__ __forceinline__ void nsa_cmp2_phase(const Params& p) {
    const int tid = ltid(), lane = tid & 63, wave = tid >> 6, fr = lane & 15, g4 = lane >> 4;
    for (int t = blockIdx.x; t < 32; t += gridDim.x) {
        const int bk = t & 15, kv = t >> 4; const int c = wave * 16 + fr;
        const bf16_t* arow = p.cmp_hid + ((size_t)(kv * 16 + bk) * 128 + c) * 256 + g4 * 8;
        const bf16_t* brow = p.w_cmp2 + (size_t)kv * 128 * 256 + (size_t)fr * 256 + g4 * 8;
        f32x4 acc[8];
#pragma unroll
        for (int i = 0; i < 8; ++i) acc[i] = (f32x4){0.f, 0.f, 0.f, 0.f};
#pragma unroll
        for (int ks = 0; ks < 8; ++ks) {
            const s16x8 af = *(const s16x8*)(arow + ks * 32);
#pragma unroll
            for (int nt = 0; nt < 8; ++nt) { const s16x8 bf = *(const s16x8*)(brow + (size_t)nt * 16 * 256 + ks * 32);
                acc[nt] = __builtin_amdgcn_mfma_f32_16x16x32_bf16(bf, af, acc[nt], 0, 0, 0); }
        }
        bf16_t* orow = p.kcvc + ((size_t)(kv * 16 + bk) * 128 + c) * 128;
#pragma unroll
        for (int nt = 0; nt < 8; ++nt) { f32x4 v = acc[nt]; if (c >= 127) v = (f32x4){0.f, 0.f, 0.f, 0.f};
            u32x2 w; w.x = pk2(v[0], v[1]); w.y = pk2(v[2], v[3]); *(u32x2*)(orow + nt * 16 + 4 * g4) = w; }
    }
}

template <bool FIRST>
__device__ __forceinline__ void nsa_add_branch(bf16_t* const (&orow)[2], const f32x4 (&O)[8][2], const float (&l)[2], const float (&gate)[2]) {
    const int g4 = (ltid() & 63) >> 4;
#pragma unroll
    for (int qt = 0; qt < 2; ++qt) { const float sc = gate[qt] / fmaxf(l[qt], 1e-30f);
#pragma unroll
        for (int dt = 0; dt < 8; ++dt) {
            u32x2* dp = (u32x2*)(orow[qt] + dt * 16 + 4 * g4);
            f32x4 o = O[dt][qt] * sc;
            if (!FIRST) { const u32x2 w = *dp;
                o[0] += __uint_as_float(w.x << 16); o[1] += __uint_as_float(w.x & 0xffff0000u); o[2] += __uint_as_float(w.y << 16); o[3] += __uint_as_float(w.y & 0xffff0000u); }
            u32x2 r; r.x = pk2(o[0], o[1]); r.y = pk2(o[2], o[3]); *dp = r; } }
}

__device__ __forceinline__ void nsa_attn_phase(const Params& p, LAS unsigned char* lds) {
    const int tid = ltid(), lane = tid & 63, wave = tid >> 6, fr = lane & 15, g4 = lane >> 4;
    LAS unsigned* RM = (LAS unsigned*)(lds + A_RMASK); LAS unsigned* UM = (LAS unsigned*)(lds + A_UMASK);
    LAS float* IMPG = (LAS float*)(lds + A_VB0);
    LAS float* IMPF = (LAS float*)(lds + A_IMP);
    for (int t = blockIdx.x; t < NB * 4 * 32; t += gridDim.x) {
        const int r_ = t >> 4, qc = (r_ & 1) ? (r_ >> 1) : (31 - (r_ >> 1)), bk = t & 15, b = bk >> 2, hk = bk & 3, q0 = qc * 64;
        __syncthreads();
        build_lut(lds, p.rel_bias, hk * 4, 4);
        if (tid == 0) UM[0] = 0u;
        __syncthreads();
        const int g = wave >> 1, head = hk * 4 + g;
        int qpos[2]; unsigned rmask[2]; const int gl = __builtin_amdgcn_readfirstlane(g); s16x8 Qf[2][4];
#pragma unroll
        for (int qt = 0; qt < 2; ++qt) {
            qpos[qt] = q0 + (wave & 1) * 32 + qt * 16 + fr; rmask[qt] = 0xFFFFFFFFu;
            const size_t tok = (size_t)(b * SEQ + qpos[qt]);
            const bf16_t* qr = p.proj + tok * NSA_LD + head * HD + g4 * 8;
#pragma unroll
            for (int ks = 0; ks < 4; ++ks) Qf[qt][ks] = *(const s16x8*)(qr + ks * 32);
        }
        f32x4 O[8][2]; float m[2], l[2];
        const float scale = 0.08838834764831845f * 1.4426950408889634f;
        {
            const bf16_t* kc = p.kcvc + (size_t)(0 * 16 + bk) * 128 * 128; const bf16_t* vc = p.kcvc + (size_t)(1 * 16 + bk) * 128 * 128;
            KVSrc<128> src{kc, 128, nullptr, 0, vc, 128, 127};
            MaskCfg mc{16, 31, 1 << 30, 31, 127, scale};
            const bool two = ((q0 + 32) >> 4) >= 64;
            unsigned long long act = two ? 3ull : 1ull;
            attn_init<2>(O, m, l);
            attn_pass<128, 2, true>(lds, src, act, mc, Qf, O, m, l, qpos, rmask, gl);
            { float gt[2];
#pragma unroll
              for (int qt = 0; qt < 2; ++qt) gt[qt] = 1.0f / (1.0f + __expf(-bf2f(p.proj[(size_t)(b * SEQ + qpos[qt]) * NSA_LD + 5120 + head * 3 + 0])));
              bf16_t* orow[2] = {p.att + (size_t)(b * SEQ + qpos[0]) * DM + head * HD, p.att + (size_t)(b * SEQ + qpos[1]) * DM + head * HD};
              nsa_add_branch<true>(orow, O, l, gt); }
            __syncthreads();
            const int qlo = wave_min_i(qpos[0] < qpos[1] ? qpos[0] : qpos[1]), qhi = wave_max_i(qpos[0] > qpos[1] ? qpos[0] : qpos[1]);
            float carry[2] = {0.f, 0.f};
            float mrf[2] = {(m[0] < -1e29f) ? 0.f : m[0], (m[1] < -1e29f) ? 0.f : m[1]};
#pragma unroll
            for (int jt = 0; jt < 2; ++jt) {
                if (jt == 0 || two) {
                    f32x4 S[4][2];
                    qk_tile<128, 2, true>(lds, jt, jt, Qf, S, mc, qpos, rmask, gl, qlo, qhi, mrf);
#pragma unroll
                    for (int qt = 0; qt < 2; ++qt) {
                        const float inv = 1.0f / fmaxf(l[qt], 1e-30f);
                        float p3[4], s4[4];
#pragma unroll
                        for (int kt = 0; kt < 4; ++kt) {
                            float pv[4];
#pragma unroll
                            for (int i = 0; i < 4; ++i) pv[i] = __builtin_amdgcn_exp2f(S[kt][qt][i]) * inv;
                            s4[kt] = (pv[0] + pv[1]) + (pv[2] + pv[3]); p3[kt] = pv[3];
                        }
#pragma unroll
                        for (int kt = 0; kt < 4; ++kt) {
                            const float fromlane = __shfl(p3[kt], (lane + 48) & 63);
                            const float wrap = __shfl(kt > 0 ? p3[kt > 0 ? kt - 1 : 0] : carry[qt], (lane + 48) & 63);
                            const float prev = (g4 > 0) ? fromlane : wrap;
                            IMPG[(g * 64 + (qpos[qt] - q0)) * 32 + jt * 16 + kt * 4 + g4] = s4[kt] + prev;
                        }
                        carry[qt] = p3[3];
                    }
                } else {
#pragma unroll
                    for (int qt = 0; qt < 2; ++qt)
#pragma unroll
                        for (int kt = 0; kt < 4; ++kt) IMPG[(g * 64 + (qpos[qt] - q0)) * 32 + 16 + kt * 4 + g4] = 0.f;
                }
            }
        }
        __syncthreads();
        for (int i = tid; i < 64 * 32; i += 512) IMPF[i] = (IMPG[i] + IMPG[2048 + i]) + (IMPG[4096 + i] + IMPG[6144 + i]);
        __syncthreads();
#pragma unroll 1
        for (int rep = 0; rep < 4; ++rep) {
            const int pair = tid + rep * 512, q = pair >> 5, j = pair & 31;
            const int qb = (q0 + q) >> 6;
            unsigned F = 1u | (1u << qb); if (qb >= 1) F |= 1u << (qb - 1);
            const int need = 16 - __builtin_popcount(F);
            const unsigned V = (qb >= 31) ? 0xFFFFFFFFu : ((2u << qb) - 1u), C = V & ~F;
            bool sel = (F >> j) & 1u;
            if ((C >> j) & 1u) {
                const float vj = IMPF[q * 32 + j]; int rank = 0;
#pragma unroll
                for (int i = 0; i < 32; ++i) { const float vi = IMPF[q * 32 + i]; rank += (((C >> i) & 1u) && (vi > vj || (vi == vj && i < j))) ? 1 : 0; }
                sel = rank < need;
            }
            const unsigned long long bal = __ballot(sel);
            if (lane == 0) { RM[q] = (unsigned)bal; atomicOr((unsigned*)UM, (unsigned)bal); }
            if (lane == 32) { RM[q] = (unsigned)(bal >> 32); atomicOr((unsigned*)UM, (unsigned)(bal >> 32)); }
        }
        __syncthreads();
        {
            rmask[0] = RM[qpos[0] - q0]; rmask[1] = RM[qpos[1] - q0];
            const unsigned um = UM[0];
            unsigned long long act = 0ull;
            for (int j = 0; j <= qc; ++j) if ((um >> j) & 1u) act |= 1ull << j;
            KVSrc<128> src{p.proj + (size_t)b * SEQ * NSA_LD + 3072 + hk * HD, (size_t)NSA_LD, nullptr, 0, p.proj + (size_t)b * SEQ * NSA_LD + 3584 + hk * HD, (size_t)NSA_LD, SEQ};
            MaskCfg mc{1, 0, 1 << 30, 6, SEQ, scale};
            attn_init<2>(O, m, l);
            attn_pass<128, 2, true>(lds, src, act, mc, Qf, O, m, l, qpos, rmask, gl);
            { float gt[2];
#pragma unroll
              for (int qt = 0; qt < 2; ++qt) gt[qt] = 1.0f / (1.0f + __expf(-bf2f(p.proj[(size_t)(b * SEQ + qpos[qt]) * NSA_LD + 5120 + head * 3 + 1])));
              bf16_t* orow[2] = {p.att + (size_t)(b * SEQ + qpos[0]) * DM + head * HD, p.att + (size_t)(b * SEQ + qpos[1]) * DM + head * HD};
              nsa_add_branch<false>(orow, O, l, gt); }
        }
        {
            rmask[0] = 0xFFFFFFFFu; rmask[1] = 0xFFFFFFFFu;
            const int tlo = (q0 - 511 < 0 ? 0 : q0 - 511) >> 6;
            unsigned long long act = 0ull;
            for (int j = tlo; j <= qc; ++j) act |= 1ull << j;
            KVSrc<128> src{p.proj + (size_t)b * SEQ * NSA_LD + 4096 + hk * HD, (size_t)NSA_LD, nullptr, 0, p.proj + (size_t)b * SEQ * NSA_LD + 4608 + hk * HD, (size_t)NSA_LD, SEQ};
            MaskCfg mc{1, 0, 512, 31, SEQ, scale};
            attn_init<2>(O, m, l);
            attn_pass<128, 2, true>(lds, src, act, mc, Qf, O, m, l, qpos, rmask, gl);
            { float gt[2];
#pragma unroll
              for (int qt = 0; qt < 2; ++qt) gt[qt] = 1.0f / (1.0f + __expf(-bf2f(p.proj[(size_t)(b * SEQ + qpos[qt]) * NSA_LD + 5120 + head * 3 + 2])));
              bf16_t* orow[2] = {p.att + (size_t)(b * SEQ + qpos[0]) * DM + head * HD, p.att + (size_t)(b * SEQ + qpos[1]) * DM + head * HD};
              nsa_add_branch<false>(orow, O, l, gt); }
        }
    }
    __syncthreads();
}

#define XB_TMO      128
#define XB_XCNT(j)  (256  + 64 * (j))
#define XB_XSUB(j)  (1280 + 64 * (j))
#define XB_XGEN(j)  (2304 + 64 * (j))
#define XB_TOP      3328
#define XB_TOPGEN   3392
#define XCD_BAR_WORDS 3456
#define XB_SPIN_CAP (1u << 18)

__device__ __forceinline__ unsigned xb_ld(unsigned* p)              { return __hip_atomic_load(p, __ATOMIC_RELAXED, __HIP_MEMORY_SCOPE_AGENT); }
__device__ __forceinline__ unsigned xb_add(unsigned* p, unsigned v) { return __hip_atomic_fetch_add(p, v, __ATOMIC_RELAXED, __HIP_MEMORY_SCOPE_AGENT); }
__device__ __forceinline__ unsigned xb_xcc_id() { return (unsigned)__builtin_amdgcn_s_getreg((3 << 11) | 20) & 0xFu; }
#define XB_SPIN(cond, bar) do { unsigned _sp = 0; while (cond) { __builtin_amdgcn_s_sleep(1); \
    if ((++_sp & 255u) == 0u) { if (xb_ld(&(bar)[XB_TMO])) break; if (_sp > XB_SPIN_CAP) { atomicAdd(&(bar)[XB_TMO], 1u); break; } } } } while (0)

struct XcdBarrier {
    unsigned* bar; unsigned x;
    volatile LAS unsigned* st;
};

__device__ __forceinline__ XcdBarrier xcd_barrier_post(unsigned* bar, volatile LAS unsigned* st) {
    XcdBarrier b; b.bar = bar; b.x = xb_xcc_id(); b.st = st;
    if (threadIdx.x == 0) (void)xb_add(&bar[XB_XCNT(b.x)], 1u);
    return b;
}
__device__ __forceinline__ void xcd_barrier_complete(unsigned* bar, unsigned x, unsigned& nloc, unsigned& nx) {
    const unsigned G = gridDim.x * gridDim.y * gridDim.z;
    unsigned sum, cnt, mine, sp = 0u;
    for (;;) {
        sum = 0u; cnt = 0u; mine = 0u;
#pragma unroll
        for (unsigned j = 0; j < 16; ++j) { const unsigned c = xb_ld(&bar[XB_XCNT(j)]); sum += c; cnt += (c > 0u) ? 1u : 0u; mine = (j == x) ? c : mine; }
        if (sum == G) break;
        __builtin_amdgcn_s_sleep(1);
        if ((++sp & 255u) == 0u) { if (xb_ld(&bar[XB_TMO])) break; if (sp > XB_SPIN_CAP) { atomicAdd(&bar[XB_TMO], 1u); break; } }
    }
    nloc = mine > 0u ? mine : 1u; nx = cnt > 0u ? cnt : 1u;
}

__device__ __forceinline__ void xcd_barrier(const XcdBarrier& b) {
    asm volatile("s_waitcnt vmcnt(0)" ::: "memory");
    __syncthreads();
    if (threadIdx.x == 0) {
        unsigned* bar = b.bar;
        __builtin_amdgcn_s_waitcnt(0);
        unsigned nloc = b.st[0], nx = b.st[1];
        if (nloc == 0u) { xcd_barrier_complete(bar, b.x, nloc, nx); b.st[0] = nloc; b.st[1] = nx; }
        const unsigned old = xb_add(&bar[XB_XSUB(b.x)], 1u);
        const unsigned gen = old / nloc;
        if (old + 1u == (gen + 1u) * nloc) {
            __builtin_amdgcn_fence(__ATOMIC_RELEASE, "agent");
            asm volatile("s_waitcnt vmcnt(0)" ::: "memory");
            const unsigned og = xb_add(&bar[XB_TOP], 1u);
            const unsigned tg = og / nx;
            if (og + 1u == (tg + 1u) * nx) xb_add(&bar[XB_TOPGEN], 1u);
            else XB_SPIN(xb_ld(&bar[XB_TOPGEN]) == tg, bar);
            __builtin_amdgcn_fence(__ATOMIC_ACQUIRE, "agent");
            xb_add(&bar[XB_XGEN(b.x)], 1u);
            asm volatile("s_waitcnt vmcnt(0)" ::: "memory");
        } else {
            XB_SPIN(xb_ld(&bar[XB_XGEN(b.x)]) == gen, bar);
            __builtin_amdgcn_fence(__ATOMIC_ACQUIRE, "agent");
            asm volatile("s_waitcnt vmcnt(0)" ::: "memory");
        }
    }
    __syncthreads();
}


typedef _Float16 h16x4 __attribute__((ext_vector_type(4)));
struct EpiResLN {
    static constexpr bool PERM = false, AFTER_DRAIN = true;
    const float* base32; const _Float16* base16; float alpha; const float* g; const float* b; float* out32; _Float16* xh; bf16_t* xb; unsigned long long* stats; unsigned* cnt; unsigned need; unsigned* tmo;
    __device__ __forceinline__ void fused(pg8::f32x4 (&acc)[2][2][4][2], const pg8::Unit& u, int wr, int wc, int fr, int fq, LAS unsigned char* lds, int wid, int lane) const {
        typedef float f32x2v __attribute__((ext_vector_type(2)));
        LAS f32x2v* P = (LAS f32x2v*)lds;
        LAS f32x2v* ST = (LAS f32x2v*)(lds + 8192);
        const int row0 = u.pm * 256 + wr * 64 + fr, col0 = u.pn * 256 + wc * 32 + 4 * fq;
#pragma unroll
        for (int ai = 0; ai < 2; ++ai)
#pragma unroll
            for (int m = 0; m < 4; ++m) {
                const size_t off = (size_t)(row0 + ai * 128 + m * 16) * DM + col0;
                float s = 0.f, q = 0.f;
#pragma unroll
                for (int bj = 0; bj < 2; ++bj)
#pragma unroll
                    for (int n = 0; n < 2; ++n) { f32x4 bs;
                        if (base32) bs = *(const f32x4*)(base32 + off + bj * 128 + n * 16);
                        else bs = __builtin_convertvector(*(const h16x4*)(base16 + off + bj * 128 + n * 16), f32x4);
                        const f32x4 v = bs * alpha + acc[ai][bj][m][n]; acc[ai][bj][m][n] = v;
                        s += (v[0] + v[1]) + (v[2] + v[3]); q += (v[0] * v[0] + v[1] * v[1]) + (v[2] * v[2] + v[3] * v[3]); }
                s = rsum32(rsum16(s)); q = rsum32(rsum16(q));
                if (fq == 0) P[(ai * 128 + wr * 64 + m * 16 + fr) * 4 + wc] = (f32x2v){s, q};
                asm volatile("" ::: "memory");
            }
        __syncthreads();
        const int tid = wid * 64 + lane;
        if (tid < 256) {
            const f32x2v a = P[tid * 4 + 0], b2 = P[tid * 4 + 1], c = P[tid * 4 + 2], d = P[tid * 4 + 3];
            const float S = (a.x + b2.x) + (c.x + d.x), Q = (a.y + b2.y) + (c.y + d.y);
            __hip_atomic_store(stats + ((size_t)(u.pm * 256 + tid) * 8 + u.pn), ((unsigned long long)__float_as_uint(Q) << 32) | __float_as_uint(S), __ATOMIC_RELAXED, __HIP_MEMORY_SCOPE_AGENT);
        }
        asm volatile("s_waitcnt vmcnt(0)" ::: "memory");
        __syncthreads();
        if (tid == 0) {
            __hip_atomic_fetch_add(cnt + 64 * u.pm, 1u, __ATOMIC_RELAXED, __HIP_MEMORY_SCOPE_AGENT);
            unsigned sp = 0;
            while (__hip_atomic_load(cnt + 64 * u.pm, __ATOMIC_RELAXED, __HIP_MEMORY_SCOPE_AGENT) < need) {
                __builtin_amdgcn_s_sleep(1);
                if (++sp > (1u << 22)) { __hip_atomic_store(tmo, 1u, __ATOMIC_RELAXED, __HIP_MEMORY_SCOPE_AGENT); break; }
            }
        }
        __syncthreads();
        if (tid < 256) {
            const unsigned long long* sp = stats + (size_t)(u.pm * 256 + tid) * 8;
            float S = 0.f, Q = 0.f;
#pragma unroll
            for (int t = 0; t < 8; ++t) { const unsigned long long w = __hip_atomic_load(sp + t, __ATOMIC_RELAXED, __HIP_MEMORY_SCOPE_AGENT); S += __uint_as_float((unsigned)w); Q += __uint_as_float((unsigned)(w >> 32)); }
            const float mean = S * (1.0f / DM), var = Q * (1.0f / DM) - mean * mean;
            ST[tid] = (f32x2v){mean, rsqrtf(fmaxf(var, 0.f) + 1e-5f)};
        }
        __syncthreads();
#pragma unroll
        for (int bj = 0; bj < 2; ++bj)
#pragma unroll
            for (int n = 0; n < 2; ++n) {
                const f32x4 gg = *(const f32x4*)(g + col0 + bj * 128 + n * 16), bb = *(const f32x4*)(b + col0 + bj * 128 + n * 16);
#pragma unroll
                for (int ai = 0; ai < 2; ++ai)
#pragma unroll
                    for (int m = 0; m < 4; ++m) {
                        const f32x2v sr = ST[ai * 128 + wr * 64 + m * 16 + fr];
                        const size_t off = (size_t)(row0 + ai * 128 + m * 16) * DM + col0 + bj * 128 + n * 16;
                        const f32x4 o = (acc[ai][bj][m][n] - sr.x) * sr.y * gg + bb;
                        if (out32) *(f32x4*)(out32 + off) = o;
                        else { *(h16x4*)(xh + off) = __builtin_convertvector(o, h16x4);
                               u32x2 w; w.x = pk2(o[0], o[1]); w.y = pk2(o[2], o[3]); *(u32x2*)(xb + off) = w; }
                    }
            }
    }
};

struct EpiMlaDown {
    static constexpr bool PERM = true, AFTER_DRAIN = false;
    bf16_t* cq; bf16_t* ckv; float* kr32; float* part;
    __device__ __forceinline__ void operator()(const pg8::f32x4 (&acc)[2][2][4][2], const pg8::Unit& u, int wr, int wc, int fr, int fq) const {
        const int row0 = u.pm * 256 + wr * 64 + fr;
        if (u.pn < 4) {
            bf16_t* dst = (u.pn < 2 ? cq : ckv) + (u.pn & 1) * 256 + wc * 32 + 8 * fq;
#pragma unroll
            for (int ai = 0; ai < 2; ++ai)
#pragma unroll
                for (int m = 0; m < 4; ++m) { const int row = row0 + ai * 128 + m * 16; float q = 0.f;
#pragma unroll
                    for (int bj = 0; bj < 2; ++bj) { const f32x4 v0 = acc[ai][bj][m][0], v1 = acc[ai][bj][m][1];
                        q += (v0[0] * v0[0] + v0[1] * v0[1]) + (v0[2] * v0[2] + v0[3] * v0[3]) + (v1[0] * v1[0] + v1[1] * v1[1]) + (v1[2] * v1[2] + v1[3] * v1[3]);
                        u32x4 w; w.x = pk2(v0[0], v0[1]); w.y = pk2(v0[2], v0[3]); w.z = pk2(v1[0], v1[1]); w.w = pk2(v1[2], v1[3]);
                        *(u32x4*)(dst + (size_t)row * 512 + bj * 128) = w; }
                    q = rsum32(rsum16(q));
                    if (fq == 0) part[(size_t)row * 16 + u.pn * 4 + wc] = q; }
        } else if (wc < 2) {
#pragma unroll
            for (int ai = 0; ai < 2; ++ai)
#pragma unroll
                for (int m = 0; m < 4; ++m) { float* rp = kr32 + (size_t)(row0 + ai * 128 + m * 16) * 64 + wc * 32 + 8 * fq;
                    *(f32x4*)rp = acc[ai][0][m][0]; *(f32x4*)(rp + 4) = acc[ai][0][m][1]; }
        }
    }
};
struct EpiBf16RowScale {
    static constexpr bool PERM = true, AFTER_DRAIN = false;
    bf16_t* O; int ldc; const float* part; int sel;
    __device__ __forceinline__ void operator()(const pg8::f32x4 (&acc)[2][2][4][2], const pg8::Unit& u, int wr, int wc, int fr, int fq) const {
        const int row0 = u.pm * 256 + wr * 64 + fr; const int col0 = u.pn * 256 + wc * 32 + 8 * fq;
#pragma unroll
        for (int ai = 0; ai < 2; ++ai)
#pragma unroll
            for (int m = 0; m < 4; ++m) { const int row = row0 + ai * 128 + m * 16;
                const f32x4 a = *(const f32x4*)(part + (size_t)row * 16 + sel * 8), b = *(const f32x4*)(part + (size_t)row * 16 + sel * 8 + 4);
                const float r = rsqrtf((((a[0] + a[1]) + (a[2] + a[3])) + ((b[0] + b[1]) + (b[2] + b[3]))) * (1.0f / 512.0f) + 1e-6f);
                bf16_t* rowp = O + (size_t)row * ldc + col0;
#pragma unroll
                for (int bj = 0; bj < 2; ++bj) { const f32x4 v0 = acc[ai][bj][m][0] * r, v1 = acc[ai][bj][m][1] * r;
                    u32x4 w; w.x = pk2(v0[0], v0[1]); w.y = pk2(v0[2], v0[3]); w.z = pk2(v1[0], v1[1]); w.w = pk2(v1[2], v1[3]);
                    *(u32x4*)(rowp + bj * 128) = w; } }
    }
};
__device__ __forceinline__ void mla_krope_step(const Params& p) {
    const int tid = ltid();
    for (int i = blockIdx.x * 512 + tid; i < NTOK * 32; i += gridDim.x * 512) {
        const int row = i >> 5, f = i & 31, s = row % SEQ;
        const float t1 = p.kr32[(size_t)row * 64 + f], t2 = p.kr32[(size_t)row * 64 + 32 + f];
        const float c = p.rope[s * 64 + f], sn = p.rope[s * 64 + 32 + f];
        p.krope[(size_t)row * 64 + f] = f2bf(t1 * c - t2 * sn); p.krope[(size_t)row * 64 + 32 + f] = f2bf(t1 * sn + t2 * c);
    }
}

template <class Epi>
__device__ __forceinline__ void run_gemm(LAS unsigned char* lds, const bf16_t* A, const bf16_t* Bt, int N, int K, const Epi& E) {
    pg8::Gemm g{A, Bt, NTOK, N, K}; pg8::StaticOrder S; S.init(NTOK, N, (int)gridDim.x, (int)blockIdx.x);
    pg8::gemm_phase<Epi, pg8::StaticOrder, false>(lds, g, S, E, nullptr);
    __syncthreads();
}

__global__ void __launch_bounds__(512) mega(Params p_unused) {
    extern __shared__ __attribute__((aligned(16))) unsigned char lds_raw[];
    LAS unsigned char* lds = (LAS unsigned char*)lds_raw;
    cg::grid_group grid = cg::this_grid();
    KP kp = (KP)__builtin_amdgcn_kernarg_segment_ptr();
    volatile LAS unsigned* stw = (volatile LAS unsigned*)(lds + 131072);
    {
        const Params& p = PK(kp);
        if (blockIdx.x == 0) for (int i = ltid(); i < XCD_BAR_WORDS; i += 512) p.bar[i] = 0u;
        if (blockIdx.x == 1) for (int i = ltid(); i < 32 * 64 + 64; i += 512) p.pcnt[i] = 0u;
        if (ltid() < 4) stw[ltid()] = 0u;
    }
    phase0(PK(kp), lds);
    grid.sync();
    XcdBarrier xbar = xcd_barrier_post(PK(kp).bar, stw);
#pragma unroll 1
    for (int L = 0; L < 4; ++L) {
        {
            const Params& p = PK(kp);
            const bf16_t* win = (L == 0) ? p.w_moba_qkv : (L == 1) ? p.w_swa_qkv : p.w_nsa_in;
            const int nin = (L == 0) ? MOBA_LD : (L == 1) ? SWA_LD : NSA_LD;
            if (L != 3) run_gemm(lds, p.xb, win, nin, DM, pg8::EpiBf16{p.proj, nin});
            else run_gemm(lds, p.xb, p.w_mla_down, MLA_DN_LD, DM, EpiMlaDown{p.cqn, p.ckvn, p.kr32, p.part});
        }
        xcd_barrier(xbar);
        if (L == 0) {
            moba_kmean_phase(PK(kp), lds);
            xcd_barrier(xbar);
            moba_attn_phase(PK(kp), lds);
        } else if (L == 1) {
            swa_attn_phase(PK(kp), lds);
        } else if (L == 2) {
            nsa_cmp1_phase(PK(kp), lds);
            xcd_barrier(xbar);
            nsa_cmp2_phase(PK(kp));
            xcd_barrier(xbar);
            nsa_attn_phase(PK(kp), lds);
        } else {
            mla_krope_step(PK(kp));
#pragma unroll 1
            for (int i = 0; i < 2; ++i) {
                const Params& p = PK(kp);
                run_gemm(lds, i ? p.ckvn : p.cqn, i ? p.w_mla_ukv : p.w_mla_uq, i ? MLA_KV_LD : MLA_Q_LD, 512,
                         EpiBf16RowScale{p.proj + (i ? (size_t)NTOK * MLA_Q_LD : 0), i ? MLA_KV_LD : MLA_Q_LD, p.part, i});
            }
            xcd_barrier(xbar);
            mla_attn_phase(PK(kp), lds);
        }
        xcd_barrier(xbar);
        {
            const Params& p = PK(kp);
            const bf16_t* wo = (L == 0) ? p.w_moba_o : (L == 1) ? p.w_swa_o : (L == 2) ? p.w_nsa_o : p.w_mla_o;
            if (L == 0) run_gemm(lds, p.att, wo, DM, DM, EpiResLN{p.x, nullptr, ALPHA_F, p.ln1_g, p.ln1_b, nullptr, p.xh, p.xb, p.stats, p.pcnt, 8u, p.pcnt + 32 * 64});
            else run_gemm(lds, p.att, wo, DM, DM, EpiResLN{nullptr, p.xh, ALPHA_F, p.ln1_g + L * DM, p.ln1_b + L * DM, nullptr, p.xh, p.xb, p.stats, p.pcnt, 8u * (unsigned)(2 * L + 1), p.pcnt + 32 * 64});
        }
        xcd_barrier(xbar);
        { const Params& p = PK(kp); run_gemm(lds, p.xb, p.w_gu + (size_t)L * 2 * DFF * DM, 2 * DFF, DM, pg8::EpiSwiGLU{p.hid, DFF}); }
        xcd_barrier(xbar);
        { const Params& p = PK(kp); run_gemm(lds, p.hid, p.w_dn + (size_t)L * DM * DFF, DM, DFF,
                                             EpiResLN{nullptr, p.xh, ALPHA_F, p.ln2_g + L * DM, p.ln2_b + L * DM, (L == 3) ? p.out : nullptr, p.xh, p.xb, p.stats, p.pcnt, 8u * (unsigned)(2 * L + 2), p.pcnt + 32 * 64}); }
        if (L < 3) xcd_barrier(xbar);
    }
}

extern "C" void kernel_launch(void* const* d_in, const int* in_sizes, int n_in, void* d_out, int out_size, void* d_ws, size_t ws_size, hipStream_t stream) {
    (void)in_sizes; (void)n_in; (void)out_size;
    static int grid_blocks = 0;
    if (!grid_blocks) {
        int dev = 0, cus = 0, per_cu = 0;
        hipGetDevice(&dev);
        hipDeviceGetAttribute(&cus, hipDeviceAttributeMultiprocessorCount, dev);
        hipFuncSetAttribute((const void*)mega, hipFuncAttributeMaxDynamicSharedMemorySize, LDS_BYTES);
        hipOccupancyMaxActiveBlocksPerMultiprocessor(&per_cu, (const void*)mega, 512, LDS_BYTES);
        if (per_cu < 1) per_cu = 1;
        grid_blocks = cus * 1;
        (void)hipGetLastError();
    }
    const float* const* in = (const float* const*)d_in;
    Params p{};
    p.x = in[0]; p.rel_bias = in[1]; p.swa_sinks = in[5]; p.cmp_pos = in[8]; p.cmp_w1 = in[9];
    p.q_norm = in[13]; p.kv_norm = in[14];
    p.ln1_g = in[18]; p.ln1_b = in[19]; p.ln2_g = in[23]; p.ln2_b = in[24];
    p.out = (float*)d_out;
    unsigned char* ws = (unsigned char*)d_ws; size_t off = 0;
    auto take = [&](size_t bytes) { unsigned char* r = ws + off; off += (bytes + 255) & ~(size_t)255; return r; };
    int nj = 0, tiles = 0;
    auto job = [&](const float* src, int K, int N, int Npad, int blk, int stride, int offr, bf16_t* dst) {
        CvtJob& j = p.jobs[nj++]; j.src = src; j.dst = dst; j.K = K; j.N = N; j.Npad = Npad; j.blk = blk; j.stride = stride; j.off = offr; j.tile0 = tiles; j.wscale = 1.0f; j.kscale = nullptr;
        tiles += ((K + 511) / 512) * (Npad / 64);
    };
    auto plain = [&](const float* src, int K, int N, int Npad) { bf16_t* d = (bf16_t*)take((size_t)Npad * K * 2); job(src, K, N, Npad, Npad, Npad, 0, d); return (const bf16_t*)d; };
    p.w_moba_qkv = plain(in[2], DM, 6144, 6144);
    p.w_moba_o = plain(in[3], DM, DM, DM);
    p.w_swa_qkv = plain(in[4], DM, 2560, 2560);
    p.w_swa_o = plain(in[6], DM, DM, DM);
    p.w_nsa_in = plain(in[7], DM, 5168, NSA_LD);
    p.w_nsa_o = plain(in[11], DM, DM, DM);
    { bf16_t* d = (bf16_t*)take((size_t)2 * 256 * 4096 * 2); p.w_cmp1 = d;
      for (int kv = 0; kv < 2; ++kv) job(in[9] + (size_t)kv * 4096 * 256, 4096, 256, 256, 256, 256, 0, d + (size_t)kv * 256 * 4096); }
    { bf16_t* d = (bf16_t*)take((size_t)2 * 128 * 256 * 2); p.w_cmp2 = d;
      for (int kv = 0; kv < 2; ++kv) job(in[10] + (size_t)kv * 256 * 128, 256, 128, 128, 128, 128, 0, d + (size_t)kv * 128 * 256); }
    p.w_mla_down = plain(in[12], DM, 1088, MLA_DN_LD);
    p.w_mla_uq = plain(in[15], 512, 3072, 3072); p.jobs[nj - 1].kscale = in[13];
    p.w_mla_ukv = plain(in[16], 512, 4096, 4096); p.jobs[nj - 1].kscale = in[14];
    p.w_mla_o = plain(in[17], DM, DM, DM);
    { bf16_t* d = (bf16_t*)take((size_t)4 * 2 * DFF * DM * 2); p.w_gu = d;
      for (int L = 0; L < 4; ++L) { job(in[20] + (size_t)L * DM * DFF, DM, DFF, DFF, 128, 256, 0, d + (size_t)L * 2 * DFF * DM); p.jobs[nj - 1].wscale = -1.4426950408889634f;
                                    job(in[21] + (size_t)L * DM * DFF, DM, DFF, DFF, 128, 256, 128, d + (size_t)L * 2 * DFF * DM); p.jobs[nj - 1].wscale = -0.6931471805599453f; } }
    { bf16_t* d = (bf16_t*)take((size_t)4 * DM * DFF * 2); p.w_dn = d;
      for (int L = 0; L < 4; ++L) job(in[22] + (size_t)L * DFF * DM, DFF, DM, DM, DM, DM, 0, d + (size_t)L * DM * DFF); }
    p.njobs = nj; p.total_tiles = tiles;
    p.xb = (bf16_t*)take((size_t)NTOK * DM * 2);
    p.xh = (_Float16*)take((size_t)NTOK * DM * 2);
    p.y = (float*)take((size_t)NTOK * DM * 4);
    p.cdown = p.y; p.kr32 = p.y; p.part = p.y + (size_t)NTOK * 64;
    p.proj = (bf16_t*)take((size_t)NTOK * 7168 * 2);
    p.hid = p.proj;
    p.att = (bf16_t*)take((size_t)NTOK * DM * 2);
    p.cqn = p.att; p.ckvn = p.att + (size_t)NTOK * 512;
    p.kmean = (float*)take((size_t)NB * NHEAD * 8 * 128 * 4);
    p.pe_b16 = (bf16_t*)take(2 * 4096 * 2);
    p.rope = (float*)take((size_t)SEQ * 64 * 4);
    p.cmp_hid = (bf16_t*)take((size_t)32 * 128 * 256 * 2);
    p.kcvc = (bf16_t*)take((size_t)32 * 128 * 128 * 2);
    p.krope = (bf16_t*)take((size_t)NTOK * 64 * 2);
    p.bar = (unsigned*)take((size_t)XCD_BAR_WORDS * 4);
    p.stats = (unsigned long long*)take((size_t)NTOK * 8 * 8);
    p.pcnt = (unsigned*)take((size_t)(32 * 64 + 64) * 4);
    if (off > ws_size || nj > NJOBS) { fprintf(stderr, "kernel_launch: workspace too small (%zu > %zu) or jobs %d\n", off, ws_size, nj); return; }
    void* args[] = {&p};
    hipError_t e = hipLaunchCooperativeKernel((const void*)mega, dim3(grid_blocks), dim3(512), args, LDS_BYTES, stream);
    if (e != hipSuccess) fprintf(stderr, "cooperative launch failed: %s (grid %d)\n", hipGetErrorString(e), grid_blocks);
}
```

```cpp
#include <hip/hip_runtime.h>
#include <hip/hip_cooperative_groups.h>
#include <cstdio>
namespace cg = cooperative_groups;
namespace pg8 {
#define PG8_LAS __attribute__((address_space(3)))
typedef unsigned short bf16_t;
typedef short bf16x8 __attribute__((ext_vector_type(8)));
typedef float f32x4 __attribute__((ext_vector_type(4)));
typedef unsigned u32x4 __attribute__((ext_vector_type(4)));
constexpr int BM = 256, BK = 64, HALF = 128, HTB = HALF * BK * 2  , STAGE_BYTES = 8 * HTB, NXCD = 8, WGM = 8;

__host__ __device__ __forceinline__ int lds_byte(int r, int c) { const int st = (r >> 4) * 2 + (c >> 5), rr = r & 15, cc = c & 31, ob = rr * 64 + cc * 2; return st * 1024 + (ob ^ (((ob >> 9) & 1) << 5)); }
__host__ __device__ __forceinline__ void stage_rc(int b, int& R, int& C) { const int st = b / 1024, sb = b % 1024, swz = sb ^ (((sb >> 9) & 1) << 5); R = (st >> 1) * 16 + swz / 64; C = (st & 1) * 32 + (swz % 64) / 2; }
__host__ __device__ __forceinline__ int perm32(int rho) { const int n = rho >> 4, i = rho & 15; return 8 * (i >> 2) + 4 * n + (i & 3); }

struct Unit { int pm, pn; };
struct Gemm { const bf16_t* A; const bf16_t* Bt; int M, N, K; };

struct StaticOrder {
    int nM, nN, nwg, G, c;
    __host__ __device__ void init(int M, int N, int G_, int c_) { nM = M / BM; nN = N / BM; nwg = nM * nN; G = G_; c = c_; }
    __host__ __device__ bool next(int i, Unit& u) const {
        const long L = (long)i * G + c; if (L >= nwg) return false;
        int wgid = (int)L; { const int q = nwg / NXCD, r = nwg % NXCD, xcd = wgid % NXCD, off = wgid / NXCD; wgid = (xcd < r ? xcd * (q + 1) : r * (q + 1) + (xcd - r) * q) + off; }
        const int nig = WGM * nN, gid = wgid / nig, fm = gid * WGM, gsz = (nM - fm) < WGM ? (nM - fm) : WGM;
        u.pm = fm + ((wgid % nig) % gsz); u.pn = (wgid % nig) / gsz; return true;
    }
    __device__ __forceinline__ void a_ready(const Unit&) const {}
    __device__ __forceinline__ void done(const Unit&) const {}
};
__device__ __forceinline__ unsigned cvt_pk_bf16(float lo, float hi) { unsigned r; asm volatile("v_cvt_pk_bf16_f32 %0, %1, %2" : "=v"(r) : "v"(lo), "v"(hi)); return r; }
typedef float f32x2 __attribute__((ext_vector_type(2)));
struct EpiF32 {
    static constexpr bool PERM = false, AFTER_DRAIN = false;
    float* C; int ldc;
    __device__ __forceinline__ void operator()(const f32x4 (&acc)[2][2][4][2], const Unit& u, int wr, int wc, int fr, int fq) const {
        const int row0 = u.pm * BM + wr * 64 + fr, col0 = u.pn * BM + wc * 32 + 4 * fq;
#pragma unroll
        for (int ai = 0; ai < 2; ++ai)
#pragma unroll
            for (int m = 0; m < 4; ++m) { float* rowp = C + (size_t)(row0 + ai * HALF + m * 16) * ldc + col0;
#pragma unroll
                for (int bj = 0; bj < 2; ++bj)
#pragma unroll
                    for (int n = 0; n < 2; ++n) *(f32x4*)(rowp + bj * HALF + n * 16) = acc[ai][bj][m][n]; }
    }
};
struct EpiRes {
    static constexpr bool PERM = false, AFTER_DRAIN = false;
    float* C; const float* base; int ldc; float alpha;
    __device__ __forceinline__ void operator()(const f32x4 (&acc)[2][2][4][2], const Unit& u, int wr, int wc, int fr, int fq) const {
        const int row0 = u.pm * BM + wr * 64 + fr, col0 = u.pn * BM + wc * 32 + 4 * fq;
#pragma unroll
        for (int ai = 0; ai < 2; ++ai)
#pragma unroll
            for (int m = 0; m < 4; ++m) { const size_t off = (size_t)(row0 + ai * HALF + m * 16) * ldc + col0;
#pragma unroll
                for (int bj = 0; bj < 2; ++bj)
#pragma unroll
                    for (int n = 0; n < 2; ++n) { const f32x4 b = *(const f32x4*)(base + off + bj * HALF + n * 16);
                        *(f32x4*)(C + off + bj * HALF + n * 16) = b * alpha + acc[ai][bj][m][n]; } }
    }
};
struct EpiBf16 {
    static constexpr bool PERM = true, AFTER_DRAIN = false;
    bf16_t* O; int ldc;
    __device__ __forceinline__ void operator()(const f32x4 (&acc)[2][2][4][2], const Unit& u, int wr, int wc, int fr, int fq) const {
        const int row0 = u.pm * BM + wr * 64 + fr; const int col0 = u.pn * BM + wc * 32 + 8 * fq;
#pragma unroll
        for (int ai = 0; ai < 2; ++ai)
#pragma unroll
            for (int m = 0; m < 4; ++m) { bf16_t* rowp = O + (size_t)(row0 + ai * HALF + m * 16) * ldc + col0;
#pragma unroll
                for (int bj = 0; bj < 2; ++bj) { const f32x4 v0 = acc[ai][bj][m][0], v1 = acc[ai][bj][m][1];
                    u32x4 w; w.x = cvt_pk_bf16(v0[0], v0[1]); w.y = cvt_pk_bf16(v0[2], v0[3]); w.z = cvt_pk_bf16(v1[0], v1[1]); w.w = cvt_pk_bf16(v1[2], v1[3]);
                    *(u32x4*)(rowp + bj * HALF) = w; } }
    }
};
__device__ __forceinline__ float silu_f(float x) { return x * __builtin_amdgcn_rcpf(1.0f + __builtin_amdgcn_exp2f(x * -1.4426950408889634f)); }
struct EpiSwiGLU {
    static constexpr bool PERM = true, AFTER_DRAIN = false;
    bf16_t* H; int ldc;
    __device__ __forceinline__ void operator()(const f32x4 (&acc)[2][2][4][2], const Unit& u, int wr, int wc, int fr, int fq) const {
        const int row0 = u.pm * BM + wr * 64 + fr; const int col0 = u.pn * HALF + wc * 32 + 8 * fq;
#pragma unroll
        for (int ai = 0; ai < 2; ++ai)
#pragma unroll
            for (int m = 0; m < 4; ++m) { bf16_t* rowp = H + (size_t)(row0 + ai * HALF + m * 16) * ldc + col0;
                f32x4 h0, h1;
#pragma unroll
                for (int j = 0; j < 4; ++j) { h0[j] = silu_f(acc[ai][0][m][0][j]) * acc[ai][1][m][0][j]; h1[j] = silu_f(acc[ai][0][m][1][j]) * acc[ai][1][m][1][j]; }
                u32x4 w; w.x = cvt_pk_bf16(h0[0], h0[1]); w.y = cvt_pk_bf16(h0[2], h0[3]); w.z = cvt_pk_bf16(h1[0], h1[1]); w.w = cvt_pk_bf16(h1[2], h1[3]);
                *(u32x4*)rowp = w; }
    }
};

template <class Epi, class Sched, bool STAMP = false>
__device__ __forceinline__ void gemm_phase(PG8_LAS unsigned char* lds, const Gemm g, const Sched& S, const Epi& E, unsigned long long* stamps) {
    int tid_l = threadIdx.x; asm volatile("" : "+v"(tid_l)); const int tid = tid_l, wid = __builtin_amdgcn_readfirstlane(tid >> 6), lane = tid & 63, wr = wid >> 2, wc = wid & 3, fr = lane & 15, fq = lane >> 4;
    const int K = g.K, nt = K / BK;
    int ts_lo = 0, ts_hi = 0, nts = 0; const unsigned long long rt_entry = STAMP ? (unsigned long long)wall_clock64() : 0ull;
#define PG8_STAMP() do { if (STAMP && wid == 0 && nts < 64) { const unsigned long long _c = (unsigned long long)clock64(); \
        ts_lo = (lane == nts) ? (int)(unsigned)_c : ts_lo; ts_hi = (lane == nts) ? (int)(unsigned)(_c >> 32) : ts_hi; ++nts; } } while (0)
    PG8_STAMP();
    unsigned voffA[2], voffB[2];
#pragma unroll
    for (int i = 0; i < 2; ++i) { int R, C; stage_rc(tid * 16 + i * 8192, R, C); const int Rb = Epi::PERM ? ((R & ~31) + perm32(R & 31)) : R;
        voffA[i] = (unsigned)(R * K + C) * 2u; voffB[i] = (unsigned)(Rb * K + C) * 2u; }
    const size_t kstep = (size_t)(BK * 2);
    const size_t hstep = (size_t)HALF * K * 2;
    const size_t tstep = 2 * hstep;
    const unsigned ldsw = (unsigned)wid * 1024u;
    const int aoff = lds_byte(wr * 64 + fr, fq * 8), boff = lds_byte(wc * 32 + fr, fq * 8);
#define PG8_SA(b, h) (((b) * 2 + (h)) * HTB)
#define PG8_SB(b, h) ((4 + (b) * 2 + (h)) * HTB)
#define PG8_STAGE(bufoff, gbase, voff) do { _Pragma("unroll") for (int _i = 0; _i < 2; ++_i) \
        __builtin_amdgcn_global_load_lds((const unsigned*)((const char*)(gbase) + (voff)[_i]), (PG8_LAS unsigned*)(lds + (bufoff) + ldsw + _i * 8192), 16, 0, 0); } while (0)
#define PG8_LDA(dst, b, h) do { _Pragma("unroll") for (int m = 0; m < 4; ++m) _Pragma("unroll") for (int k = 0; k < 2; ++k) dst[m][k] = *(const PG8_LAS bf16x8*)(lds + PG8_SA(b, h) + aoff + m * 2048 + k * 1024); } while (0)
#define PG8_LDB(dst, b, h) do { _Pragma("unroll") for (int n = 0; n < 2; ++n) _Pragma("unroll") for (int k = 0; k < 2; ++k) dst[n][k] = *(const PG8_LAS bf16x8*)(lds + PG8_SB(b, h) + boff + n * 2048 + k * 1024); } while (0)
#define PG8_MMA(ai, bj, At, Bt) do { __builtin_amdgcn_s_setprio(1); _Pragma("unroll") for (int m = 0; m < 4; ++m) _Pragma("unroll") for (int n = 0; n < 2; ++n) _Pragma("unroll") for (int k = 0; k < 2; ++k) \
        acc[ai][bj][m][n] = __builtin_amdgcn_mfma_f32_16x16x32_bf16(Bt[n][k], At[m][k], acc[ai][bj][m][n], 0, 0, 0); __builtin_amdgcn_s_setprio(0); } while (0)
#define PG8_WAIT_V(n) asm volatile("s_waitcnt vmcnt(" #n ")" ::: "memory")
#define PG8_WAIT_L(n) asm volatile("s_waitcnt lgkmcnt(" #n ")" ::: "memory")
#define PG8_BAR __builtin_amdgcn_s_barrier()
#define PG8_SCHED __builtin_amdgcn_sched_barrier(0)
    Unit cur, nxt; int ui = 0;
    if (!S.next(0, cur)) return;
    f32x4 acc[2][2][4][2];
#pragma unroll
    for (int a = 0; a < 2; ++a)
#pragma unroll
        for (int b = 0; b < 2; ++b)
#pragma unroll
            for (int m = 0; m < 4; ++m)
#pragma unroll
                for (int n = 0; n < 2; ++n) acc[a][b][m][n] = (f32x4){0.f, 0.f, 0.f, 0.f};
    bf16x8 At[4][2], B0[2][2], B1[2][2];
    const char* cA = (const char*)g.A + (size_t)cur.pm * tstep; const char* cB = (const char*)g.Bt + (size_t)cur.pn * tstep;
    S.a_ready(cur);
    PG8_STAGE(PG8_SB(0, 0), cB, voffB); PG8_STAGE(PG8_SA(0, 0), cA, voffA); PG8_STAGE(PG8_SB(0, 1), cB + hstep, voffB); PG8_STAGE(PG8_SA(0, 1), cA + hstep, voffA);
    if (wr == 1) PG8_BAR;
    PG8_WAIT_V(4); PG8_BAR;
    PG8_STAGE(PG8_SB(1, 0), cB + kstep, voffB); PG8_STAGE(PG8_SA(1, 0), cA + kstep, voffA); PG8_STAGE(PG8_SB(1, 1), cB + hstep + kstep, voffB);
    PG8_WAIT_V(6); PG8_BAR;
    PG8_STAMP();
    for (;;) {
        const bool has_next = S.next(ui + 1, nxt);
        const char* nA = has_next ? (const char*)g.A + (size_t)nxt.pm * tstep : cA; const char* nB = has_next ? (const char*)g.Bt + (size_t)nxt.pn * tstep : cB;
        for (int t = 0; t < nt; t += 2) {
            const bool last = (t == nt - 2);
            const char* a1 = cA + (size_t)(t + 1) * kstep;
            const char* a2 = last ? nA : cA + (size_t)(t + 2) * kstep; const char* b2 = last ? nB : cB + (size_t)(t + 2) * kstep;
            const char* a3 = a2 + kstep; const char* b3 = b2 + kstep;
            if (last && has_next) S.a_ready(nxt);
            PG8_LDB(B0, 0, 0); PG8_SCHED; PG8_LDA(At, 0, 0); PG8_STAGE(PG8_SA(1, 1), a1 + hstep, voffA);
            PG8_WAIT_L(8); PG8_BAR; PG8_WAIT_L(0); PG8_MMA(0, 0, At, B0); PG8_BAR; PG8_SCHED;
            PG8_LDB(B1, 0, 1); PG8_STAGE(PG8_SB(0, 0), b2, voffB);
            PG8_BAR; PG8_WAIT_L(0); PG8_MMA(0, 1, At, B1); PG8_BAR;
            PG8_LDA(At, 0, 1); PG8_STAGE(PG8_SA(0, 0), a2, voffA);
            PG8_BAR; PG8_WAIT_L(0); PG8_MMA(1, 0, At, B0); PG8_BAR; PG8_SCHED;
            PG8_STAGE(PG8_SB(0, 1), b2 + hstep, voffB);
            PG8_WAIT_V(6); PG8_BAR; PG8_MMA(1, 1, At, B1); PG8_BAR;
            PG8_LDB(B0, 1, 0); PG8_SCHED; PG8_LDA(At, 1, 0); PG8_STAGE(PG8_SA(0, 1), a2 + hstep, voffA);
            PG8_WAIT_L(8); PG8_BAR; PG8_WAIT_L(0); PG8_MMA(0, 0, At, B0); PG8_BAR; PG8_SCHED;
            PG8_LDB(B1, 1, 1); PG8_STAGE(PG8_SB(1, 0), b3, voffB);
            PG8_BAR; PG8_WAIT_L(0); PG8_MMA(0, 1, At, B1); PG8_BAR;
            PG8_LDA(At, 1, 1); PG8_STAGE(PG8_SA(1, 0), a3, voffA);
            PG8_BAR; PG8_WAIT_L(0); PG8_MMA(1, 0, At, B0); PG8_BAR; PG8_SCHED;
            PG8_STAGE(PG8_SB(1, 1), b3 + hstep, voffB);
            PG8_WAIT_V(6); PG8_BAR; PG8_MMA(1, 1, At, B1); PG8_BAR;
        }
        PG8_STAMP();
        if constexpr (!Epi::AFTER_DRAIN) { E(acc, cur, wr, wc, fr, fq); S.done(cur); }
        PG8_STAMP();
        if (!has_next) break;
#pragma unroll
        for (int a = 0; a < 2; ++a)
#pragma unroll
            for (int b = 0; b < 2; ++b)
#pragma unroll
                for (int m = 0; m < 4; ++m)
#pragma unroll
                    for (int n = 0; n < 2; ++n) acc[a][b][m][n] = (f32x4){0.f, 0.f, 0.f, 0.f};
        cur = nxt; cA = nA; cB = nB; ++ui;
    }
    PG8_WAIT_V(0);
    if (wr == 0) PG8_BAR;
    PG8_BAR;
    if constexpr (Epi::AFTER_DRAIN) { E.fused(acc, cur, wr, wc, fr, fq, lds, wid, lane); S.done(cur); }
    PG8_STAMP();
    if (STAMP && wid == 0) { stamps[lane] = lane < nts ? (((unsigned long long)(unsigned)ts_hi << 32) | (unsigned)ts_lo) : 0ull;
        if (lane == 62) stamps[62] = rt_entry; if (lane == 63) stamps[63] = (unsigned long long)wall_clock64(); }
#undef PG8_STAMP
#undef PG8_SA
#undef PG8_SB
#undef PG8_STAGE
#undef PG8_LDA
#undef PG8_LDB
#undef PG8_MMA
#undef PG8_WAIT_V
#undef PG8_WAIT_L
#undef PG8_BAR
#undef PG8_SCHED
}
}

#define LAS __attribute__((address_space(3)))
typedef unsigned short bf16_t;
typedef short s16x8 __attribute__((ext_vector_type(8)));
typedef short s16x4 __attribute__((ext_vector_type(4)));
typedef float f32x4 __attribute__((ext_vector_type(4)));
typedef unsigned u32x4 __attribute__((ext_vector_type(4)));
typedef unsigned u32x2 __attribute__((ext_vector_type(2)));

constexpr int DM = 2048, NB = 4, SEQ = 2048, NTOK = NB * SEQ, DFF = 5632, NHEAD = 16, HD = 128;
constexpr int NSA_LD = 5376, MOBA_LD = 6144, SWA_LD = 2560, MLA_DN_LD = 1280, MLA_Q_LD = 3072, MLA_KV_LD = 4096;
constexpr float ALPHA_F = 1.681792830507429f;
constexpr int LDS_BYTES = 131072 + 16;
constexpr int NJOBS = 26;

struct CvtJob { const float* src; bf16_t* dst; const float* kscale; int K, N, Npad, blk, stride, off, tile0, pad; };
struct Params {
    const float* x; const float* rel_bias; const float* swa_sinks; const float* cmp_pos; const float* cmp_w1;
    const float* q_norm; const float* kv_norm;
    const float* ln1_g; const float* ln1_b; const float* ln2_g; const float* ln2_b;
    float* out;
    const bf16_t* w_moba_qkv; const bf16_t* w_moba_o; const bf16_t* w_swa_qkv; const bf16_t* w_swa_o;
    const bf16_t* w_nsa_in; const bf16_t* w_nsa_o; const bf16_t* w_cmp1; const bf16_t* w_cmp2;
    const bf16_t* w_mla_down; const bf16_t* w_mla_uq; const bf16_t* w_mla_ukv; const bf16_t* w_mla_o;
    const bf16_t* w_gu; const bf16_t* w_dn;
    bf16_t* xb; _Float16* xh; float* y; bf16_t* proj; bf16_t* hid; bf16_t* att;
    float* kmean; bf16_t* pe_b16; float* rope; bf16_t* cmp_hid; bf16_t* kcvc; float* cdown; bf16_t* cqn; bf16_t* ckvn; bf16_t* krope; float* kr32; float* part;
    unsigned* bar; unsigned long long* stats; unsigned* pcnt;
    CvtJob jobs[NJOBS];
    int njobs, total_tiles;
};

typedef const __attribute__((address_space(4))) Params* KP;
__device__ __forceinline__ const Params& PK(KP kp) { asm volatile("" : "+s"(kp)); return *(const Params*)kp; }
__device__ __forceinline__ int ltid() { int t = threadIdx.x; asm volatile("" : "+v"(t)); return t; }
__device__ __forceinline__ float bf2f(bf16_t b) { return __uint_as_float(((unsigned)b) << 16); }
__device__ __forceinline__ bf16_t f2bf(float f) { unsigned u = __float_as_uint(f); u += 0x7FFFu + ((u >> 16) & 1u); return (bf16_t)(u >> 16); }
__device__ __forceinline__ unsigned pk2(float lo, float hi) { unsigned r; asm("v_cvt_pk_bf16_f32 %0, %1, %2" : "=v"(r) : "v"(lo), "v"(hi)); return r; }

__device__ __forceinline__ void phase0(const Params& p, LAS unsigned char* lds) {
    const int tid = ltid();
    for (int t = blockIdx.x; t < p.total_tiles; t += gridDim.x) {
        int ji = 0;
#pragma unroll 1
        for (int j = 1; j < p.njobs; ++j) if (t >= p.jobs[j].tile0) ji = j;
        const CvtJob jb = p.jobs[ji];
        const int lt = t - jb.tile0, ntn = jb.Npad >> 6, tk = lt / ntn, tn = lt % ntn;
        const int gn = tn * 64 + (tid & 63), k0 = tk * 512 + (tid >> 6) * 64;
        if (k0 >= jb.K) continue;
        float v[64];
        if (gn < jb.N) {
            const float* sp = jb.src + (size_t)k0 * jb.N + gn;
#pragma unroll
            for (int i = 0; i < 64; ++i) v[i] = __builtin_nontemporal_load(sp + (size_t)i * jb.N);
        } else {
#pragma unroll
            for (int i = 0; i < 64; ++i) v[i] = 0.f;
        }
        if (jb.kscale) {
#pragma unroll
            for (int i = 0; i < 64; ++i) v[i] *= jb.kscale[k0 + i];
        }
        {
            const int row = (gn / jb.blk) * jb.stride + jb.off + (gn % jb.blk);
            bf16_t* dp = jb.dst + (size_t)row * jb.K + k0;
#pragma unroll
            for (int i = 0; i < 8; ++i) { u32x4 w; w.x = pk2(v[8 * i], v[8 * i + 1]); w.y = pk2(v[8 * i + 2], v[8 * i + 3]); w.z = pk2(v[8 * i + 4], v[8 * i + 5]); w.w = pk2(v[8 * i + 6], v[8 * i + 7]);
                *(u32x4*)(dp + 8 * i) = w; }
        }
    }
    {
        const size_t n8 = (size_t)NTOK * DM / 8;
        for (size_t i = (size_t)blockIdx.x * 512 + tid; i < n8; i += (size_t)gridDim.x * 512) {
            const f32x4 a = *(const f32x4*)(p.x + i * 8), b = *(const f32x4*)(p.x + i * 8 + 4);
            u32x4 w; w.x = pk2(a[0], a[1]); w.y = pk2(a[2], a[3]); w.z = pk2(b[0], b[1]); w.w = pk2(b[2], b[3]);
            *(u32x4*)(p.xb + i * 8) = w;
        }
    }
    for (int i = blockIdx.x * 512 + tid; i < SEQ * 32; i += gridDim.x * 512) {
        const int s = i >> 5, f = i & 31;
        const float inv = exp2f(-(float)(2 * f) * (13.287712379549449f / 64.0f));
        const float ang = (float)s * inv;
        const double a = (double)ang, k = rint(a * 0.15915494309189535);
        const float r = (float)(a - k * 6.283185307179586);
        p.rope[s * 64 + f] = __cosf(r); p.rope[s * 64 + 32 + f] = __sinf(r);
    }
    for (int i = blockIdx.x * 512 + tid; i < 2 * 4096; i += gridDim.x * 512) p.pe_b16[i] = f2bf(p.cmp_pos[i]);
}

__device__ __forceinline__ void ln_phase(const float* y, const float* g, const float* b, float* xf, bf16_t* xb) {
    const int tid = ltid(), lane = tid & 63, wave = tid >> 6;
    for (int row = blockIdx.x * 8 + wave; row < NTOK; row += gridDim.x * 8) {
        const float* yr = y + (size_t)row * DM;
        f32x4 v[8]; float s = 0.f;
#pragma unroll
        for (int i = 0; i < 8; ++i) { v[i] = *(const f32x4*)(yr + i * 256 + lane * 4); s += (v[i][0] + v[i][1]) + (v[i][2] + v[i][3]); }
#pragma unroll
        for (int o = 32; o > 0; o >>= 1) s += __shfl_xor(s, o);
        const float mean = s * (1.0f / DM); float q = 0.f;
#pragma unroll
        for (int i = 0; i < 8; ++i) { const f32x4 d = v[i] - mean; q += (d[0] * d[0] + d[1] * d[1]) + (d[2] * d[2] + d[3] * d[3]); }
#pragma unroll
        for (int o = 32; o > 0; o >>= 1) q += __shfl_xor(q, o);
        const float rstd = rsqrtf(q * (1.0f / DM) + 1e-5f);
#pragma unroll
        for (int i = 0; i < 8; ++i) {
            const int c = i * 256 + lane * 4;
            const f32x4 gg = *(const f32x4*)(g + c), bb = *(const f32x4*)(b + c);
            const f32x4 o = (v[i] - mean) * rstd * gg + bb;
            *(f32x4*)(xf + (size_t)row * DM + c) = o;
            if (xb) { u32x2 w; w.x = pk2(o[0], o[1]); w.y = pk2(o[2], o[3]); *(u32x2*)(xb + (size_t)row * DM + c) = w; }
        }
    }
}

constexpr int A_KB0 = 0, A_KBSZ = 25600, A_VB0 = 51200, A_VBSZ = 18432, A_LUT = 106496, A_LUTS = 132, A_RMASK = 110720, A_UMASK = 111744, A_IMP = 111872, A_IMPF = 120064;
constexpr int VSTR = 288;
constexpr float NEG_BIG = -1e30f;

__device__ __forceinline__ s16x4 vtr(const LAS unsigned char* pp) {
    typedef short v4i16_t __attribute__((ext_vector_type(4)));
    return __builtin_bit_cast(s16x4, __builtin_amdgcn_ds_read_tr16_b64_v4i16((LAS v4i16_t*)pp));
}

__device__ __forceinline__ int t5_bucket_dev(int n) {
    if (n < 16) return n;
    const float nf = (float)n;
    int large = 16 + (int)(logf(nf / 16.0f) / 2.0794415416798357f * 16.0f);
    return large < 31 ? large : 31;
}
__device__ __forceinline__ void build_lut(LAS unsigned char* lds, const float* rel_bias, int h0, int G) {
    LAS float* L = (LAS float*)(lds + A_LUT);
    for (int i = ltid(); i < G * 129; i += 512) { const int g = i / 129, d = i % 129; L[g * A_LUTS + d] = rel_bias[t5_bucket_dev(d) * NHEAD + h0 + g] * 1.4426950408889634f; }
}

template <int DQK>
struct KVSrc { const bf16_t* K; size_t ldk; const bf16_t* K2; size_t ldk2; const bf16_t* V; size_t ldv; int nk; };

template <int DQK>
struct KVPlan { const char* kp; const char* vp; const char* rp; unsigned kstep, vstep, rstep, klo, vlo, rlo; };
template <>
struct KVPlan<128> { const char* kp; const char* vp; unsigned kstep, vstep, klo, vlo; };
__device__ __forceinline__ void kv_plan(const KVSrc<128>& s, KVPlan<128>& pl) {
    const int tid = ltid(), row = tid >> 4, ch = tid & 15;
    pl.kp = (const char*)(s.K + (size_t)row * s.ldk + ch * 8); pl.vp = (const char*)(s.V + (size_t)row * s.ldv + ch * 8);
    pl.kstep = (unsigned)(s.ldk * 64); pl.vstep = (unsigned)(s.ldv * 64);
    pl.klo = (unsigned)(row * 272 + ch * 16); pl.vlo = (unsigned)(row * VSTR + ch * 16);
}
__device__ __forceinline__ void kv_gload(const KVPlan<128>& pl, int jt, u32x4 (&kr)[2], u32x4 (&vr)[2]) {
#pragma unroll
    for (int i = 0; i < 2; ++i) { kr[i] = *(const u32x4*)(pl.kp + (size_t)(2 * jt + i) * pl.kstep); vr[i] = *(const u32x4*)(pl.vp + (size_t)(2 * jt + i) * pl.vstep); }
}
__device__ __forceinline__ void kv_lstore(LAS unsigned char* lds, int kbuf, int vbuf, const KVPlan<128>& pl, const u32x4 (&kr)[2], const u32x4 (&vr)[2]) {
#pragma unroll
    for (int i = 0; i < 2; ++i) { *(LAS u32x4*)(lds + A_KB0 + kbuf * A_KBSZ + pl.klo + i * 32 * 272) = kr[i]; *(LAS u32x4*)(lds + A_VB0 + vbuf * A_VBSZ + pl.vlo + i * 32 * VSTR) = vr[i]; }
}
__device__ __forceinline__ void kv_plan(const KVSrc<192>& s, KVPlan<192>& pl) {
    const int tid = ltid(), row = tid >> 4, ch = tid & 15, rrow = tid >> 3, rch = tid & 7;
    pl.kp = (const char*)(s.K + (size_t)row * s.ldk + ch * 8); pl.vp = (const char*)(s.V + (size_t)row * s.ldv + ch * 8);
    pl.rp = (const char*)(s.K2 + (size_t)rrow * s.ldk2 + rch * 8);
    pl.kstep = (unsigned)(s.ldk * 64); pl.vstep = (unsigned)(s.ldv * 64); pl.rstep = (unsigned)(s.ldk2 * 128);
    pl.klo = (unsigned)(row * 400 + ch * 16); pl.vlo = (unsigned)(row * VSTR + ch * 16); pl.rlo = (unsigned)(rrow * 400 + 256 + rch * 16);
}
__device__ __forceinline__ void kv_gload(const KVPlan<192>& pl, int jt, u32x4 (&kr)[3], u32x4 (&vr)[2]) {
#pragma unroll
    for (int i = 0; i < 2; ++i) { kr[i] = *(const u32x4*)(pl.kp + (size_t)(2 * jt + i) * pl.kstep); vr[i] = *(const u32x4*)(pl.vp + (size_t)(2 * jt + i) * pl.vstep); }
    kr[2] = *(const u32x4*)(pl.rp + (size_t)jt * pl.rstep);
}
__device__ __forceinline__ void kv_lstore(LAS unsigned char* lds, int kbuf, int vbuf, const KVPlan<192>& pl, const u32x4 (&kr)[3], const u32x4 (&vr)[2]) {
#pragma unroll
    for (int i = 0; i < 2; ++i) { *(LAS u32x4*)(lds + A_KB0 + kbuf * A_KBSZ + pl.klo + i * 32 * 400) = kr[i]; *(LAS u32x4*)(lds + A_VB0 + vbuf * A_VBSZ + pl.vlo + i * 32 * VSTR) = vr[i]; }
    *(LAS u32x4*)(lds + A_KB0 + kbuf * A_KBSZ + pl.rlo) = kr[2];
}

struct MaskCfg { int KS, KO, W, bsh, nk; float scale; };

__device__ __forceinline__ float rmax16(float x) { auto r = __builtin_amdgcn_permlane16_swap(__float_as_uint(x), __float_as_uint(x), false, false); return fmaxf(__uint_as_float(r[0]), __uint_as_float(r[1])); }
__device__ __forceinline__ float rmax32(float x) { auto r = __builtin_amdgcn_permlane32_swap(__float_as_uint(x), __float_as_uint(x), false, false); return fmaxf(__uint_as_float(r[0]), __uint_as_float(r[1])); }
__device__ __forceinline__ float rsum16(float x) { auto r = __builtin_amdgcn_permlane16_swap(__float_as_uint(x), __float_as_uint(x), false, false); return __uint_as_float(r[0]) + __uint_as_float(r[1]); }
__device__ __forceinline__ float rsum32(float x) { auto r = __builtin_amdgcn_permlane32_swap(__float_as_uint(x), __float_as_uint(x), false, false); return __uint_as_float(r[0]) + __uint_as_float(r[1]); }
__device__ __forceinline__ int wave_min_i(int v) {
#pragma unroll
    for (int o = 1; o < 64; o <<= 1) { const int t = __shfl_xor(v, o); v = t < v ? t : v; }
    return __builtin_amdgcn_readfirstlane(v);
}
__device__ __forceinline__ int wave_max_i(int v) {
#pragma unroll
    for (int o = 1; o < 64; o <<= 1) { const int t = __shfl_xor(v, o); v = t > v ? t : v; }
    return __builtin_amdgcn_readfirstlane(v);
}

template <int DQK, int QT, bool BIAS>
__device__ __forceinline__ void qk_tile(LAS unsigned char* lds, int buf, int jt, const s16x8 (&Qf)[QT][DQK / 32], f32x4 (&S)[4][QT],
                                        const MaskCfg& mc, const int (&qpos)[QT], const unsigned (&rmask)[QT], int gl, int qlo_w, int qhi_w, const float (&mref)[QT]) {
    constexpr int KSTR = DQK * 2 + 16;
    const int lane = ltid() & 63, fr = lane & 15, g4 = lane >> 4;
    const LAS unsigned char* kb = lds + A_KB0 + buf * A_KBSZ + fr * KSTR + g4 * 16;
    {
        constexpr int NKS = DQK / 32, NF = 4 * NKS;
        __builtin_amdgcn_s_setprio(1);
        s16x8 kf[3];
        kf[0] = *(const LAS s16x8*)(kb);
        kf[1] = *(const LAS s16x8*)(kb + 64);
#pragma unroll
        for (int f = 0; f < NF; ++f) {
            const int kt = f / NKS, ks = f % NKS;
            if (f + 2 < NF) { const int kt2 = (f + 2) / NKS, ks2 = (f + 2) % NKS; kf[(f + 2) % 3] = *(const LAS s16x8*)(kb + kt2 * 16 * KSTR + ks2 * 64); }
            if (ks == 0) {
#pragma unroll
                for (int qt = 0; qt < QT; ++qt) S[kt][qt] = (f32x4){0.f, 0.f, 0.f, 0.f};
            }
#pragma unroll
            for (int qt = 0; qt < QT; ++qt) S[kt][qt] = __builtin_amdgcn_mfma_f32_16x16x32_bf16(kf[f % 3], Qf[qt][ks], S[kt][qt], 0, 0, 0);
        }
        __builtin_amdgcn_sched_group_barrier(0x100, 2, 0);
#pragma unroll
        for (int f = 0; f < NF; ++f) {
            if (f + 2 < NF) __builtin_amdgcn_sched_group_barrier(0x100, 1, 0);
            __builtin_amdgcn_sched_group_barrier(0x008, QT, 0);
        }
        __builtin_amdgcn_s_setprio(0);
    }
    const LAS float* L = (const LAS float*)(lds + A_LUT);
    const int kmin = jt * 64 * mc.KS + mc.KO, kmax = (jt * 64 + 63) * mc.KS + mc.KO;
    const bool slow = (kmax > qlo_w) || (qhi_w - kmin >= mc.W) || (jt * 64 + 63 >= mc.nk) || (BIAS && (qlo_w - kmax < 128));
    if (!slow) {
#pragma unroll
        for (int qt = 0; qt < QT; ++qt) {
            const bool rowok = (rmask[qt] >> ((jt * 64) >> mc.bsh)) & 1u;
            const float a = rowok ? mc.scale : 0.f;
            float c = rowok ? -mref[qt] : NEG_BIG;
            if (BIAS) c = rowok ? L[gl * A_LUTS + 128] - mref[qt] : NEG_BIG;
#pragma unroll
            for (int kt = 0; kt < 4; ++kt)
#pragma unroll
                for (int i = 0; i < 4; ++i) S[kt][qt][i] = __builtin_fmaf(S[kt][qt][i], a, c);
        }
    } else {
        const int j0 = jt * 64 + g4 * 4;
#pragma unroll
        for (int qt = 0; qt < QT; ++qt) {
            const int d0 = qpos[qt] - (j0 * mc.KS + mc.KO);
#pragma unroll
            for (int kt = 0; kt < 4; ++kt) {
                float bv[4];
#pragma unroll
                for (int i = 0; i < 4; ++i) {
                    const int dist = d0 - (kt * 16 + i) * mc.KS;
                    const int dd = dist < 0 ? 0 : (dist > 128 ? 128 : dist);
                    bv[i] = BIAS ? L[gl * A_LUTS + dd] : 0.f;
                }
#pragma unroll
                for (int i = 0; i < 4; ++i) {
                    const int j = j0 + kt * 16 + i;
                    const int dist = d0 - (kt * 16 + i) * mc.KS;
                    const unsigned ok = (unsigned)(dist >= 0) & (unsigned)(dist < mc.W) & (unsigned)(j < mc.nk) & ((rmask[qt] >> (j >> mc.bsh)) & 1u);
                    const float s = __builtin_fmaf(S[kt][qt][i], mc.scale, bv[i] - mref[qt]);
                    S[kt][qt][i] = ok ? s : NEG_BIG;
                }
            }
        }
    }
}

template <int QT>
__device__ __forceinline__ void pv_tile(LAS unsigned char* lds, int vbuf, const s16x8 (&Pf)[2][QT], f32x4 (&O)[8][QT]) {
    const int lane = ltid() & 63, g4 = lane >> 4, q4 = (lane & 15) >> 2, p4 = lane & 3;
    const LAS unsigned char* vb = lds + A_VB0 + vbuf * A_VBSZ + (4 * g4 + q4) * VSTR + p4 * 8;
    __builtin_amdgcn_s_setprio(1);
    s16x4 va[3], vb2[3];
    va[0] = vtr(vb); vb2[0] = vtr(vb + 16 * VSTR);
    va[1] = vtr(vb + 32); vb2[1] = vtr(vb + 16 * VSTR + 32);
#pragma unroll
    for (int f = 0; f < 16; ++f) {
        const int kk = f >> 3, dt = f & 7;
        if (f + 2 < 16) { const int kk2 = (f + 2) >> 3, dt2 = (f + 2) & 7; va[(f + 2) % 3] = vtr(vb + (kk2 * 32) * VSTR + dt2 * 32); vb2[(f + 2) % 3] = vtr(vb + (kk2 * 32 + 16) * VSTR + dt2 * 32); }
        const s16x4 v0 = va[f % 3], v1 = vb2[f % 3];
        const s16x8 vf = (s16x8){v0[0], v0[1], v0[2], v0[3], v1[0], v1[1], v1[2], v1[3]};
#pragma unroll
        for (int qt = 0; qt < QT; ++qt) O[dt][qt] = __builtin_amdgcn_mfma_f32_16x16x32_bf16(vf, Pf[kk][qt], O[dt][qt], 0, 0, 0);
    }
    __builtin_amdgcn_sched_group_barrier(0x100, 4, 1);
#pragma unroll
    for (int f = 0; f < 16; ++f) {
        if (f + 2 < 16) __builtin_amdgcn_sched_group_barrier(0x100, 2, 1);
        __builtin_amdgcn_sched_group_barrier(0x008, QT, 1);
    }
    __builtin_amdgcn_s_setprio(0);
}

template <int DQK, int QT, bool BIAS, bool LAG = true>
__device__ __forceinline__ void attn_pass(LAS unsigned char* lds, const KVSrc<DQK>& src, unsigned long long act, const MaskCfg& mc,
                                          const s16x8 (&Qf)[QT][DQK / 32], f32x4 (&O)[8][QT], float (&m)[QT], float (&l)[QT],
                                          const int (&qpos)[QT], const unsigned (&rmask)[QT], int gl) {
    const int tidv = ltid(), lane = tidv & 63, g4 = lane >> 4;
    const bool lag = LAG && (__builtin_amdgcn_readfirstlane(tidv >> 8) != 0);
    if (act == 0ull) return;
    int qlo_w, qhi_w;
    { int a = qpos[0], b = qpos[0];
#pragma unroll
      for (int qt = 1; qt < QT; ++qt) { a = qpos[qt] < a ? qpos[qt] : a; b = qpos[qt] > b ? qpos[qt] : b; }
      qlo_w = wave_min_i(a); qhi_w = wave_max_i(b); }
    u32x4 kr[DQK / 64], vr[2];
    KVPlan<DQK> pl; kv_plan(src, pl);
    int jt = __builtin_ctzll(act); act &= act - 1ull;
    kv_gload(pl, jt, kr, vr);
    __syncthreads();
    kv_lstore(lds, 0, 0, pl, kr, vr);
    __syncthreads();
    int kbuf = 0, vbuf = 0;
    float lp[QT];
#pragma unroll
    for (int qt = 0; qt < QT; ++qt) lp[qt] = (g4 == 0) ? l[qt] : 0.f;
    s16x8 Pf[2][QT];
    bool havep = false;
    for (;;) {
        const bool has_next = (act != 0ull);
        int jn = 0;
        if (has_next) { jn = __builtin_ctzll(act); act &= act - 1ull; kv_gload(pl, jn, kr, vr); }
        if (lag && havep) { pv_tile<QT>(lds, vbuf == 0 ? 2 : vbuf - 1, Pf, O); havep = false; }
        const bool skip = ((jt * 64) * mc.KS + mc.KO > qhi_w) || (qlo_w - ((jt * 64 + 63) * mc.KS + mc.KO) >= mc.W);
        if (!skip) {
        f32x4 S[4][QT];
        float mref[QT];
#pragma unroll
        for (int qt = 0; qt < QT; ++qt) mref[qt] = (m[qt] < -1e29f) ? 0.f : m[qt];
        qk_tile<DQK, QT, BIAS>(lds, kbuf, jt, Qf, S, mc, qpos, rmask, gl, qlo_w, qhi_w, mref);
#pragma unroll
        for (int qt = 0; qt < QT; ++qt) {
            float mx = NEG_BIG;
#pragma unroll
            for (int kt = 0; kt < 4; ++kt)
#pragma unroll
                for (int i = 0; i < 4; ++i) mx = fmaxf(mx, S[kt][qt][i]);
            mx = rmax16(mx); mx = rmax32(mx);
            const float mold_rel = (m[qt] < -1e29f) ? NEG_BIG : 0.f;
            const float mnew_rel = fmaxf(mold_rel, mx);
            const float muse = (mnew_rel < -1e29f) ? 0.f : mnew_rel;
            const bool grow = (mold_rel < -1e29f) ? (mx > -1e29f) : (mx > 10.0f);
            if (__any(grow)) {
                const float alpha = __builtin_amdgcn_exp2f(mold_rel - mnew_rel);
#pragma unroll
                for (int kt = 0; kt < 4; ++kt)
#pragma unroll
                    for (int i = 0; i < 4; ++i) S[kt][qt][i] = __builtin_amdgcn_exp2f(S[kt][qt][i] - muse);
#pragma unroll
                for (int dt = 0; dt < 8; ++dt) O[dt][qt] *= alpha;
                lp[qt] *= alpha;
                m[qt] = mnew_rel + mref[qt];
            } else {
#pragma unroll
                for (int kt = 0; kt < 4; ++kt)
#pragma unroll
                    for (int i = 0; i < 4; ++i) S[kt][qt][i] = __builtin_amdgcn_exp2f(S[kt][qt][i]);
            }
            { f32x4 sv = (S[0][qt] + S[1][qt]) + (S[2][qt] + S[3][qt]); lp[qt] += (sv[0] + sv[1]) + (sv[2] + sv[3]); }
#pragma unroll
            for (int kk = 0; kk < 2; ++kk) {
                u32x4 w; w.x = pk2(S[2 * kk][qt][0], S[2 * kk][qt][1]); w.y = pk2(S[2 * kk][qt][2], S[2 * kk][qt][3]);
                w.z = pk2(S[2 * kk + 1][qt][0], S[2 * kk + 1][qt][1]); w.w = pk2(S[2 * kk + 1][qt][2], S[2 * kk + 1][qt][3]);
                Pf[kk][qt] = __builtin_bit_cast(s16x8, w);
            }
        }
        havep = true;
        if (!lag) pv_tile<QT>(lds, vbuf, Pf, O);
        }
        if (!has_next) break;
        const int vnext = vbuf == 2 ? 0 : vbuf + 1;
        kv_lstore(lds, kbuf ^ 1, vnext, pl, kr, vr);
        __syncthreads();
        kbuf ^= 1; vbuf = vnext; jt = jn;
    }
    if (lag && havep) pv_tile<QT>(lds, vbuf, Pf, O);
#pragma unroll
    for (int qt = 0; qt < QT; ++qt) l[qt] = rsum32(rsum16(lp[qt]));
}

template <int QT>
__device__ __forceinline__ void attn_init(f32x4 (&O)[8][QT], float (&m)[QT], float (&l)[QT]) {
#pragma unroll
    for (int qt = 0; qt < QT; ++qt) { m[qt] = NEG_BIG; l[qt] = 0.f;
#pragma unroll
        for (int dt = 0; dt < 8; ++dt) O[dt][qt] = (f32x4){0.f, 0.f, 0.f, 0.f}; }
}
template <int QT>
__device__ __forceinline__ void attn_store(const f32x4 (&O)[8][QT], const float (&l)[QT], bf16_t* const (&orow)[QT]) {
    const int g4 = (ltid() & 63) >> 4;
#pragma unroll
    for (int qt = 0; qt < QT; ++qt) { const float inv = 1.0f / fmaxf(l[qt], 1e-30f);
#pragma unroll
        for (int dt = 0; dt < 8; ++dt) { const f32x4 o = O[dt][qt] * inv; u32x2 w; w.x = pk2(o[0], o[1]); w.y = pk2(o[2], o[3]); *(u32x2*)(orow[qt] + dt * 16 + 4 * g4) = w; } }
}
__device__ __forceinline__ int qc_order(int t, int per, int nq) { const int r = t / per; const int q = r % nq; return (r / nq) * 0 + ((r & 1) ? q : (nq - 1 - q)); }

__device__ __forceinline__ void moba_kmean_phase(const Params& p, LAS unsigned char* lds) {
    const int tid = ltid(); LAS float* R = (LAS float*)lds;
    for (int job = blockIdx.x; job < NB * NHEAD * 8; job += gridDim.x) {
        const int blk = job & 7, h = (job >> 3) & 15, b = job >> 7;
        const int d8 = (tid & 15) * 8, jg = tid >> 4;
        float acc[8];
#pragma unroll
        for (int e = 0; e < 8; ++e) acc[e] = 0.f;
#pragma unroll
        for (int i = 0; i < 8; ++i) {
            const int j = jg + 32 * i;
            const s16x8 v = *(const s16x8*)(p.proj + (size_t)(b * SEQ + blk * 256 + j) * MOBA_LD + 2048 + h * HD + d8);
#pragma unroll
            for (int e = 0; e < 8; ++e) acc[e] += bf2f((bf16_t)v[e]);
        }
        __syncthreads();
#pragma unroll
        for (int e = 0; e < 8; ++e) R[jg * 128 + d8 + e] = acc[e];
        __syncthreads();
        if (tid < 128) { float s = 0.f; for (int g = 0; g < 32; ++g) s += R[g * 128 + tid]; p.kmean[(size_t)job * 128 + tid] = s * (1.0f / 256.0f); }
    }
    __syncthreads();
}

__device__ __forceinline__ void moba_attn_phase(const Params& p, LAS unsigned char* lds) {
    const int tid = ltid(), lane = tid & 63, wave = tid >> 6, fr = lane & 15, g4 = lane >> 4;
    LAS unsigned* RM = (LAS unsigned*)(lds + A_RMASK); LAS unsigned* UM = (LAS unsigned*)(lds + A_UMASK);
    for (int t = blockIdx.x; t < NB * NHEAD * 8; t += gridDim.x) {
        const int per = NB * NHEAD, n = (t / per) < 4 ? (7 - t / per) : (t / per - 4), bh = t % per, b = bh >> 4, h = bh & 15;
        __syncthreads();
        build_lut(lds, p.rel_bias, h, 1);
        if (tid == 0) UM[0] = 0u;
        __syncthreads();
        if (tid < 256) {
            unsigned mask = 1u << n;
            if (n <= 3) mask |= (1u << n) - 1u;
            else {
                const bf16_t* qr = p.proj + (size_t)(b * SEQ + n * 256 + tid) * MOBA_LD + h * HD;
                float g0 = 0.f, g1 = 0.f, g2 = 0.f, g3 = 0.f, g5 = 0.f, g6 = 0.f, g7 = 0.f;
                float gate[7];
#pragma unroll
                for (int j = 0; j < 7; ++j) gate[j] = 0.f;
                const float* km = p.kmean + (size_t)(b * NHEAD + h) * 8 * 128;
                for (int d8 = 0; d8 < 128; d8 += 8) {
                    const s16x8 qv = *(const s16x8*)(qr + d8);
#pragma unroll
                    for (int j = 0; j < 7; ++j) if (j < n) {
                        const f32x4 k0 = *(const f32x4*)(km + j * 128 + d8), k1 = *(const f32x4*)(km + j * 128 + d8 + 4);
#pragma unroll
                        for (int e = 0; e < 4; ++e) gate[j] += bf2f((bf16_t)qv[e]) * k0[e] + bf2f((bf16_t)qv[4 + e]) * k1[e];
                    }
                }
                (void)g0; (void)g1; (void)g2; (void)g3; (void)g5; (void)g6; (void)g7;
                unsigned picked = 0u;
#pragma unroll
                for (int r = 0; r < 3; ++r) {
                    float best = -3e38f; int bi = 0;
#pragma unroll
                    for (int j = 0; j < 7; ++j) if (j < n && !((picked >> j) & 1u) && gate[j] > best) { best = gate[j]; bi = j; }
                    picked |= 1u << bi;
                }
                mask |= picked;
            }
            RM[tid] = mask; atomicOr((unsigned*)UM, mask);
        }
        __syncthreads();
        const unsigned um = UM[0];
        unsigned long long act = 0ull;
        for (int j = 0; j <= n; ++j) if ((um >> j) & 1u) act |= 0xFull << (4 * j);
        int qpos[2]; unsigned rmask[2]; int gl = 0; s16x8 Qf[2][4]; bf16_t* orow[2];
#pragma unroll
        for (int qt = 0; qt < 2; ++qt) {
            const int r = wave * 32 + qt * 16 + fr; qpos[qt] = n * 256 + r; rmask[qt] = RM[r];
            const bf16_t* qr = p.proj + (size_t)(b * SEQ + qpos[qt]) * MOBA_LD + h * HD + g4 * 8;
#pragma unroll
            for (int ks = 0; ks < 4; ++ks) Qf[qt][ks] = *(const s16x8*)(qr + ks * 32);
            orow[qt] = p.att + (size_t)(b * SEQ + qpos[qt]) * DM + h * HD;
        }
        KVSrc<128> src{p.proj + (size_t)b * SEQ * MOBA_LD + 2048 + h * HD, (size_t)MOBA_LD, nullptr, 0, p.proj + (size_t)b * SEQ * MOBA_LD + 4096 + h * HD, (size_t)MOBA_LD, SEQ};
        MaskCfg mc{1, 0, 1 << 30, 8, SEQ, 0.08838834764831845f * 1.4426950408889634f};
        f32x4 O[8][2]; float m[2], l[2];
        attn_init<2>(O, m, l);
        attn_pass<128, 2, true>(lds, src, act, mc, Qf, O, m, l, qpos, rmask, gl);
        attn_store<2>(O, l, orow);
    }
    __syncthreads();
}

__device__ __forceinline__ void swa_attn_phase(const Params& p, LAS unsigned char* lds) {
    const int tid = ltid(), lane = tid & 63, wave = tid >> 6, fr = lane & 15, g4 = lane >> 4;
    for (int t = blockIdx.x; t < NB * 2 * 64; t += gridDim.x) {
        const int qc = t >> 3, bk = t & 7, b = bk >> 1, hk = bk & 1, q0 = qc * 32;
        __syncthreads();
        build_lut(lds, p.rel_bias, hk * 8, 8);
        __syncthreads();
        int qpos[2]; unsigned rmask[2]; int gl = 0; s16x8 Qf[2][4]; bf16_t* orow[2];
        const int head = hk * 8 + wave;
#pragma unroll
        for (int qt = 0; qt < 2; ++qt) {
            qpos[qt] = q0 + qt * 16 + fr; rmask[qt] = 0xFFFFFFFFu; gl = __builtin_amdgcn_readfirstlane(wave);
            const bf16_t* qr = p.proj + (size_t)(b * SEQ + qpos[qt]) * SWA_LD + head * HD + g4 * 8;
#pragma unroll
            for (int ks = 0; ks < 4; ++ks) Qf[qt][ks] = *(const s16x8*)(qr + ks * 32);
            orow[qt] = p.att + (size_t)(b * SEQ + qpos[qt]) * DM + head * HD;
        }
        KVSrc<128> src{p.proj + (size_t)b * SEQ * SWA_LD + 2048 + hk * HD, (size_t)SWA_LD, nullptr, 0, p.proj + (size_t)b * SEQ * SWA_LD + 2304 + hk * HD, (size_t)SWA_LD, SEQ};
        MaskCfg mc{1, 0, 128, 31, SEQ, 0.08838834764831845f * 1.4426950408889634f};
        const int tlo = (q0 - 127 < 0 ? 0 : q0 - 127) >> 6, thi = (q0 + 31) >> 6;
        unsigned long long act = 0ull;
        for (int j = tlo; j <= thi; ++j) act |= 1ull << j;
        f32x4 O[8][2]; float m[2], l[2];
        attn_init<2>(O, m, l);
        const float sink = p.swa_sinks[head] * 1.4426950408889634f;
        m[0] = sink; m[1] = sink; l[0] = 1.f; l[1] = 1.f;
        attn_pass<128, 2, true>(lds, src, act, mc, Qf, O, m, l, qpos, rmask, gl);
        attn_store<2>(O, l, orow);
    }
    __syncthreads();
}

__device__ __forceinline__ void mla_norm_phase(const Params& p) {
    const int tid = ltid(), lane = tid & 63, wave = tid >> 6;
    for (int row = blockIdx.x * 8 + wave; row < NTOK; row += gridDim.x * 8) {
        const float* cr = p.cdown + (size_t)row * MLA_DN_LD;
#pragma unroll
        for (int part = 0; part < 2; ++part) {
            f32x4 v[2]; float s = 0.f;
#pragma unroll
            for (int i = 0; i < 2; ++i) { v[i] = *(const f32x4*)(cr + part * 512 + i * 256 + lane * 4); s += (v[i][0] * v[i][0] + v[i][1] * v[i][1]) + (v[i][2] * v[i][2] + v[i][3] * v[i][3]); }
#pragma unroll
            for (int o = 32; o > 0; o >>= 1) s += __shfl_xor(s, o);
            const float r = rsqrtf(s * (1.0f / 512.0f) + 1e-6f);
            const float* gw = part ? p.kv_norm : p.q_norm; bf16_t* dst = (part ? p.ckvn : p.cqn) + (size_t)row * 512;
#pragma unroll
            for (int i = 0; i < 2; ++i) { const int c = i * 256 + lane * 4; const f32x4 gg = *(const f32x4*)(gw + c); const f32x4 o = v[i] * r * gg;
                u32x2 w; w.x = pk2(o[0], o[1]); w.y = pk2(o[2], o[3]); *(u32x2*)(dst + c) = w; }
        }
        if (lane < 32) {
            const int s = row % SEQ; const float t1 = cr[1024 + lane], t2 = cr[1024 + 32 + lane];
            const float c = p.rope[s * 64 + lane], sn = p.rope[s * 64 + 32 + lane];
            p.krope[(size_t)row * 64 + lane] = f2bf(t1 * c - t2 * sn); p.krope[(size_t)row * 64 + 32 + lane] = f2bf(t1 * sn + t2 * c);
        }
    }
}

__device__ __forceinline__ void mla_attn_phase(const Params& p, LAS unsigned char* lds) {
    const int tid = ltid(), lane = tid & 63, wave = tid >> 6, fr = lane & 15, g4 = lane >> 4;
    for (int t = blockIdx.x; t < NB * NHEAD * 8; t += gridDim.x) {
        const int per = NB * NHEAD, n = (t / per) < 4 ? (7 - t / per) : (t / per - 4), bh = t % per, b = bh >> 4, h = bh & 15;
        int qpos[2]; unsigned rmask[2]; int gl = 0; s16x8 Qf[2][6]; bf16_t* orow[2];
#pragma unroll
        for (int qt = 0; qt < 2; ++qt) {
            const int r = wave * 32 + qt * 16 + fr; qpos[qt] = n * 256 + r; rmask[qt] = 0xFFFFFFFFu;
            const bf16_t* qr = p.proj + (size_t)(b * SEQ + qpos[qt]) * MLA_Q_LD + h * 192 + g4 * 8;
#pragma unroll
            for (int ks = 0; ks < 6; ++ks) Qf[qt][ks] = *(const s16x8*)(qr + ks * 32);
            const float* rp = p.rope + qpos[qt] * 64 + g4 * 8;
            s16x8 a = Qf[qt][4], c2 = Qf[qt][5];
#pragma unroll
            for (int e = 0; e < 8; ++e) { const float t1 = bf2f((bf16_t)a[e]), t2 = bf2f((bf16_t)c2[e]), cs = rp[e], sn = rp[32 + e];
                a[e] = (short)f2bf(t1 * cs - t2 * sn); c2[e] = (short)f2bf(t1 * sn + t2 * cs); }
            Qf[qt][4] = a; Qf[qt][5] = c2;
            orow[qt] = p.att + (size_t)(b * SEQ + qpos[qt]) * DM + h * HD;
        }
        const bf16_t* kvb = p.proj + (size_t)NTOK * MLA_Q_LD + (size_t)b * SEQ * MLA_KV_LD + h * 256;
        KVSrc<192> src{kvb, (size_t)MLA_KV_LD, p.krope + (size_t)b * SEQ * 64, 64, kvb + 128, (size_t)MLA_KV_LD, SEQ};
        MaskCfg mc{1, 0, 1 << 30, 31, SEQ, 0.07216878364870322f * 1.4426950408889634f};
        unsigned long long act = 0ull;
        for (int j = 0; j < 4 * (n + 1); ++j) act |= 1ull << j;
        f32x4 O[8][2]; float m[2], l[2];
        attn_init<2>(O, m, l);
        attn_pass<192, 2, false, false>(lds, src, act, mc, Qf, O, m, l, qpos, rmask, gl);
        attn_store<2>(O, l, orow);
    }
    __syncthreads();
}

__device__ __forceinline__ float gelu_tanh(float x) { const float u = 0.7978845608028654f * (x + 0.044715f * x * x * x); const float e = __expf(2.0f * u); const float th = 1.0f - 2.0f * __builtin_amdgcn_rcpf(e + 1.0f); return 0.5f * x * (1.0f + th); }

__device__ __forceinline__ void nsa_cmp1_phase(const Params& p, LAS unsigned char* lds) {
    const int tid = ltid(), lane = tid & 63, wave = tid >> 6, fr = lane & 15, g4 = lane >> 4;
    for (int t = blockIdx.x; t < 256; t += gridDim.x) {
        const int nq = t & 7, bk = (t >> 3) & 15, kv = t >> 7, b = bk >> 2, hk = bk & 3;
        const int c = wave * 16 + fr;
        const bf16_t* arow = (c < 127) ? p.proj + (size_t)(b * SEQ + c * 16) * NSA_LD + 2048 + kv * 512 + hk * HD + g4 * 8 : p.pe_b16 + kv * 4096 + g4 * 8;
        const size_t lstr = (c < 127) ? (size_t)NSA_LD : (size_t)128;
        const bf16_t* brow = p.w_cmp1 + (size_t)kv * 256 * 4096 + (size_t)(nq * 32 + fr) * 4096 + g4 * 8;
        f32x4 acc[2];
#pragma unroll
        for (int i = 0; i < 2; ++i) acc[i] = (f32x4){0.f, 0.f, 0.f, 0.f};
#pragma unroll 1
        for (int l8 = 0; l8 < 32; l8 += 2) {
            s16x8 af[8], bf[8][2];
#pragma unroll
            for (int u = 0; u < 8; ++u) { const int ks = l8 * 4 + u;
                af[u] = *(const s16x8*)(arow + (size_t)(ks >> 2) * lstr + (ks & 3) * 32);
                bf[u][0] = *(const s16x8*)(brow + ks * 32); bf[u][1] = *(const s16x8*)(brow + (size_t)16 * 4096 + ks * 32); }
#pragma unroll
            for (int u = 0; u < 8; ++u) { acc[0] = __builtin_amdgcn_mfma_f32_16x16x32_bf16(bf[u][0], af[u], acc[0], 0, 0, 0); acc[1] = __builtin_amdgcn_mfma_f32_16x16x32_bf16(bf[u][1], af[u], acc[1], 0, 0, 0); }
        }
        LAS float* PB = (LAS float*)lds;
        __syncthreads();
        if (c == 127) {
#pragma unroll
            for (int nt = 0; nt < 2; ++nt) *(LAS f32x4*)(PB + nt * 16 + 4 * g4) = acc[nt];
        }
        __syncthreads();
        bf16_t* orow = p.cmp_hid + ((size_t)(kv * 16 + bk) * 128 + c) * 256 + nq * 32;
#pragma unroll
        for (int nt = 0; nt < 2; ++nt) { const int n0 = nt * 16 + 4 * g4; const f32x4 pb = *(const LAS f32x4*)(PB + n0);
            const f32x4 v = acc[nt] + pb; u32x2 w; w.x = pk2(gelu_tanh(v[0]), gelu_tanh(v[1])); w.y = pk2(gelu_tanh(v[2]), gelu_tanh(v[3])); *(u32x2*)(orow + n0) = w; }
    }
}
__device__ __forceinline__ void nsa_cmp2_phase(const Params& p) {
    const int tid = ltid(), lane = tid & 63, wave = tid >> 6, fr = lane & 15, g4 = lane >> 4;
    for (int t = blockIdx.x; t < 32; t += gridDim.x) {
        const int bk = t & 15, kv = t >> 4; const int c = wave * 16 + fr;
        const bf16_t* arow = p.cmp_hid + ((size_t)(kv * 16 + bk) * 128 + c) * 256 + g4 * 8;
        const bf16_t* brow = p.w_cmp2 + (size_t)kv * 128 * 256 + (size_t)fr * 256 + g4 * 8;
        f32x4 acc[8];
#pragma unroll
        for (int i = 0; i < 8; ++i) acc[i] = (f32x4){0.f, 0.f, 0.f, 0.f};
#pragma unroll
        for (int ks = 0; ks < 8; ++ks) {
            const s16x8 af = *(const s16x8*)(arow + ks * 32);
#pragma unroll
            for (int nt = 0; nt < 8; ++nt) { const s16x8 bf = *(const s16x8*)(brow + (size_t)nt * 16 * 256 + ks * 32);
                acc[nt] = __builtin_amdgcn_mfma_f32_16x16x32_bf16(bf, af, acc[nt], 0, 0, 0); }
        }
        bf16_t* orow = p.kcvc + ((size_t)(kv * 16 + bk) * 128 + c) * 128;
#pragma unroll
        for (int nt = 0; nt < 8; ++nt) { f32x4 v = acc[nt]; if (c >= 127) v = (f32x4){0.f, 0.f, 0.f, 0.f};
            u32x2 w; w.x = pk2(v[0], v[1]); w.y = pk2(v[2], v[3]); *(u32x2*)(orow + nt * 16 + 4 * g4) = w; }
    }
}

template <bool FIRST>
__device__ __forceinline__ void nsa_add_branch(bf16_t* const (&orow)[2], const f32x4 (&O)[8][2], const float (&l)[2], const float (&gate)[2]) {
    const int g4 = (ltid() & 63) >> 4;
#pragma unroll
    for (int qt = 0; qt < 2; ++qt) { const float sc = gate[qt] / fmaxf(l[qt], 1e-30f);
#pragma unroll
        for (int dt = 0; dt < 8; ++dt) {
            u32x2* dp = (u32x2*)(orow[qt] + dt * 16 + 4 * g4);
            f32x4 o = O[dt][qt] * sc;
            if (!FIRST) { const u32x2 w = *dp;
                o[0] += __uint_as_float(w.x << 16); o[1] += __uint_as_float(w.x & 0xffff0000u); o[2] += __uint_as_float(w.y << 16); o[3] += __uint_as_float(w.y & 0xffff0000u); }
            u32x2 r; r.x = pk2(o[0], o[1]); r.y = pk2(o[2], o[3]); *dp = r; } }
}

__device__ __forceinline__ void nsa_attn_phase(const Params& p, LAS unsigned char* lds) {
    const int tid = ltid(), lane = tid & 63, wave = tid >> 6, fr = lane & 15, g4 = lane >> 4;
    LAS unsigned* RM = (LAS unsigned*)(lds + A_RMASK); LAS unsigned* UM = (LAS unsigned*)(lds + A_UMASK);
    LAS float* IMPG = (LAS float*)(lds + A_VB0);
    LAS float* IMPF = (LAS float*)(lds + A_IMP);
    for (int t = blockIdx.x; t < NB * 4 * 32; t += gridDim.x) {
        const int r_ = (t >> 4) & 31, qc = (r_ < 16) ? (31 - r_) : (r_ - 16), bk = t & 15, b = bk >> 2, hk = bk & 3, q0 = qc * 64;
        __syncthreads();
        build_lut(lds, p.rel_bias, hk * 4, 4);
        if (tid == 0) UM[0] = 0u;
        __syncthreads();
        const int g = wave >> 1, head = hk * 4 + g;
        int qpos[2]; unsigned rmask[2]; const int gl = __builtin_amdgcn_readfirstlane(g); s16x8 Qf[2][4];
#pragma unroll
        for (int qt = 0; qt < 2; ++qt) {
            qpos[qt] = q0 + (wave & 1) * 32 + qt * 16 + fr; rmask[qt] = 0xFFFFFFFFu;
            const size_t tok = (size_t)(b * SEQ + qpos[qt]);
            const bf16_t* qr = p.proj + tok * NSA_LD + head * HD + g4 * 8;
#pragma unroll
            for (int ks = 0; ks < 4; ++ks) Qf[qt][ks] = *(const s16x8*)(qr + ks * 32);
        }
        f32x4 O[8][2]; float m[2], l[2];
        const float scale = 0.08838834764831845f * 1.4426950408889634f;
        {
            const bf16_t* kc = p.kcvc + (size_t)(0 * 16 + bk) * 128 * 128; const bf16_t* vc = p.kcvc + (size_t)(1 * 16 + bk) * 128 * 128;
            KVSrc<128> src{kc, 128, nullptr, 0, vc, 128, 127};
            MaskCfg mc{16, 31, 1 << 30, 31, 127, scale};
            const bool two = ((q0 + 32) >> 4) >= 64;
            unsigned long long act = two ? 3ull : 1ull;
            attn_init<2>(O, m, l);
            attn_pass<128, 2, true>(lds, src, act, mc, Qf, O, m, l, qpos, rmask, gl);
            { float gt[2];
#pragma unroll
              for (int qt = 0; qt < 2; ++qt) gt[qt] = 1.0f / (1.0f + __expf(-bf2f(p.proj[(size_t)(b * SEQ + qpos[qt]) * NSA_LD + 5120 + head * 3 + 0])));
              bf16_t* orow[2] = {p.att + (size_t)(b * SEQ + qpos[0]) * DM + head * HD, p.att + (size_t)(b * SEQ + qpos[1]) * DM + head * HD};
              nsa_add_branch<true>(orow, O, l, gt); }
            __syncthreads();
            const int qlo = wave_min_i(qpos[0] < qpos[1] ? qpos[0] : qpos[1]), qhi = wave_max_i(qpos[0] > qpos[1] ? qpos[0] : qpos[1]);
            float carry[2] = {0.f, 0.f};
            float mrf[2] = {(m[0] < -1e29f) ? 0.f : m[0], (m[1] < -1e29f) ? 0.f : m[1]};
#pragma unroll
            for (int jt = 0; jt < 2; ++jt) {
                if (jt == 0 || two) {
                    f32x4 S[4][2];
                    qk_tile<128, 2, true>(lds, jt, jt, Qf, S, mc, qpos, rmask, gl, qlo, qhi, mrf);
#pragma unroll
                    for (int qt = 0; qt < 2; ++qt) {
                        const float inv = 1.0f / fmaxf(l[qt], 1e-30f);
                        float p3[4], s4[4];
#pragma unroll
                        for (int kt = 0; kt < 4; ++kt) {
                            float pv[4];
#pragma unroll
                            for (int i = 0; i < 4; ++i) pv[i] = __builtin_amdgcn_exp2f(S[kt][qt][i]) * inv;
                            s4[kt] = (pv[0] + pv[1]) + (pv[2] + pv[3]); p3[kt] = pv[3];
                        }
#pragma unroll
                        for (int kt = 0; kt < 4; ++kt) {
                            const float fromlane = __shfl(p3[kt], (lane + 48) & 63);
                            const float wrap = __shfl(kt > 0 ? p3[kt > 0 ? kt - 1 : 0] : carry[qt], (lane + 48) & 63);
                            const float prev = (g4 > 0) ? fromlane : wrap;
                            IMPG[(g * 64 + (qpos[qt] - q0)) * 32 + jt * 16 + kt * 4 + g4] = s4[kt] + prev;
                        }
                        carry[qt] = p3[3];
                    }
                } else {
#pragma unroll
                    for (int qt = 0; qt < 2; ++qt)
#pragma unroll
                        for (int kt = 0; kt < 4; ++kt) IMPG[(g * 64 + (qpos[qt] - q0)) * 32 + 16 + kt * 4 + g4] = 0.f;
                }
            }
        }
        __syncthreads();
        for (int i = tid; i < 64 * 32; i += 512) IMPF[i] = (IMPG[i] + IMPG[2048 + i]) + (IMPG[4096 + i] + IMPG[6144 + i]);
        __syncthreads();
#pragma unroll 1
        for (int rep = 0; rep < 4; ++rep) {
            const int pair = tid + rep * 512, q = pair >> 5, j = pair & 31;
            const int qb = (q0 + q) >> 6;
            unsigned F = 1u | (1u << qb); if (qb >= 1) F |= 1u << (qb - 1);
            const int need = 16 - __builtin_popcount(F);
            const unsigned V = (qb >= 31) ? 0xFFFFFFFFu : ((2u << qb) - 1u), C = V & ~F;
            bool sel = (F >> j) & 1u;
            if ((C >> j) & 1u) {
                const float vj = IMPF[q * 32 + j]; int rank = 0;
#pragma unroll
                for (int i = 0; i < 32; ++i) { const float vi = IMPF[q * 32 + i]; rank += (((C >> i) & 1u) && (vi > vj || (vi == vj && i < j))) ? 1 : 0; }
                sel = rank < need;
            }
            const unsigned long long bal = __ballot(sel);
            if (lane == 0) { RM[q] = (unsigned)bal; atomicOr((unsigned*)UM, (unsigned)bal); }
            if (lane == 32) { RM[q] = (unsigned)(bal >> 32); atomicOr((unsigned*)UM, (unsigned)(bal >> 32)); }
        }
        __syncthreads();
        {
            rmask[0] = RM[qpos[0] - q0]; rmask[1] = RM[qpos[1] - q0];
            const unsigned um = UM[0];
            unsigned long long act = 0ull;
            for (int j = 0; j <= qc; ++j) if ((um >> j) & 1u) act |= 1ull << j;
            KVSrc<128> src{p.proj + (size_t)b * SEQ * NSA_LD + 3072 + hk * HD, (size_t)NSA_LD, nullptr, 0, p.proj + (size_t)b * SEQ * NSA_LD + 3584 + hk * HD, (size_t)NSA_LD, SEQ};
            MaskCfg mc{1, 0, 1 << 30, 6, SEQ, scale};
            attn_init<2>(O, m, l);
            attn_pass<128, 2, true>(lds, src, act, mc, Qf, O, m, l, qpos, rmask, gl);
            { float gt[2];
#pragma unroll
              for (int qt = 0; qt < 2; ++qt) gt[qt] = 1.0f / (1.0f + __expf(-bf2f(p.proj[(size_t)(b * SEQ + qpos[qt]) * NSA_LD + 5120 + head * 3 + 1])));
              bf16_t* orow[2] = {p.att + (size_t)(b * SEQ + qpos[0]) * DM + head * HD, p.att + (size_t)(b * SEQ + qpos[1]) * DM + head * HD};
              nsa_add_branch<false>(orow, O, l, gt); }
        }
        {
            rmask[0] = 0xFFFFFFFFu; rmask[1] = 0xFFFFFFFFu;
            const int tlo = (q0 - 511 < 0 ? 0 : q0 - 511) >> 6;
            unsigned long long act = 0ull;
            for (int j = tlo; j <= qc; ++j) act |= 1ull << j;
            KVSrc<128> src{p.proj + (size_t)b * SEQ * NSA_LD + 4096 + hk * HD, (size_t)NSA_LD, nullptr, 0, p.proj + (size_t)b * SEQ * NSA_LD + 4608 + hk * HD, (size_t)NSA_LD, SEQ};
            MaskCfg mc{1, 0, 512, 31, SEQ, scale};
            attn_init<2>(O, m, l);
            attn_pass<128, 2, true>(lds, src, act, mc, Qf, O, m, l, qpos, rmask, gl);
            { float gt[2];
#pragma unroll
              for (int qt = 0; qt < 2; ++qt) gt[qt] = 1.0f / (1.0f + __expf(-bf2f(p.proj[(size_t)(b * SEQ + qpos[qt]) * NSA_LD + 5120 + head * 3 + 2])));
              bf16_t* orow[2] = {p.att + (size_t)(b * SEQ + qpos[0]) * DM + head * HD, p.att + (size_t)(b * SEQ + qpos[1]) * DM + head * HD};
              nsa_add_branch<false>(orow, O, l, gt); }
        }
    }
    __syncthreads();
}

#define XB_TMO      128
#define XB_XCNT(j)  (256  + 64 * (j))
#define XB_XSUB(j)  (1280 + 64 * (j))
#define XB_XGEN(j)  (2304 + 64 * (j))
#define XB_TOP      3328
#define XB_TOPGEN   3392
#define XCD_BAR_WORDS 3456
#define XB_SPIN_CAP (1u << 18)

__device__ __forceinline__ unsigned xb_ld(unsigned* p)              { return __hip_atomic_load(p, __ATOMIC_RELAXED, __HIP_MEMORY_SCOPE_AGENT); }
__device__ __forceinline__ unsigned xb_add(unsigned* p, unsigned v) { return __hip_atomic_fetch_add(p, v, __ATOMIC_RELAXED, __HIP_MEMORY_SCOPE_AGENT); }
__device__ __forceinline__ unsigned xb_xcc_id() { return (unsigned)__builtin_amdgcn_s_getreg((3 << 11) | 20) & 0xFu; }
#define XB_SPIN(cond, bar) do { unsigned _sp = 0; while (cond) { __builtin_amdgcn_s_sleep(1); \
    if ((++_sp & 255u) == 0u) { if (xb_ld(&(bar)[XB_TMO])) break; if (_sp > XB_SPIN_CAP) { atomicAdd(&(bar)[XB_TMO], 1u); break; } } } } while (0)

struct XcdBarrier {
    unsigned* bar; unsigned x;
    volatile LAS unsigned* st;
};

__device__ __forceinline__ XcdBarrier xcd_barrier_post(unsigned* bar, volatile LAS unsigned* st) {
    XcdBarrier b; b.bar = bar; b.x = xb_xcc_id(); b.st = st;
    if (threadIdx.x == 0) (void)xb_add(&bar[XB_XCNT(b.x)], 1u);
    return b;
}
__device__ __forceinline__ void xcd_barrier_complete(unsigned* bar, unsigned x, unsigned& nloc, unsigned& nx) {
    const unsigned G = gridDim.x * gridDim.y * gridDim.z;
    unsigned sum, cnt, mine, sp = 0u;
    for (;;) {
        sum = 0u; cnt = 0u; mine = 0u;
#pragma unroll
        for (unsigned j = 0; j < 16; ++j) { const unsigned c = xb_ld(&bar[XB_XCNT(j)]); sum += c; cnt += (c > 0u) ? 1u : 0u; mine = (j == x) ? c : mine; }
        if (sum == G) break;
        __builtin_amdgcn_s_sleep(1);
        if ((++sp & 255u) == 0u) { if (xb_ld(&bar[XB_TMO])) break; if (sp > XB_SPIN_CAP) { atomicAdd(&bar[XB_TMO], 1u); break; } }
    }
    nloc = mine > 0u ? mine : 1u; nx = cnt > 0u ? cnt : 1u;
}

__device__ __forceinline__ void xcd_barrier(const XcdBarrier& b) {
    asm volatile("s_waitcnt vmcnt(0)" ::: "memory");
    __syncthreads();
    if (threadIdx.x == 0) {
        unsigned* bar = b.bar;
        __builtin_amdgcn_s_waitcnt(0);
        unsigned nloc = b.st[0], nx = b.st[1];
        if (nloc == 0u) { xcd_barrier_complete(bar, b.x, nloc, nx); b.st[0] = nloc; b.st[1] = nx; }
        const unsigned old = xb_add(&bar[XB_XSUB(b.x)], 1u);
        const unsigned gen = old / nloc;
        if (old + 1u == (gen + 1u) * nloc) {
            __builtin_amdgcn_fence(__ATOMIC_RELEASE, "agent");
            asm volatile("s_waitcnt vmcnt(0)" ::: "memory");
            const unsigned og = xb_add(&bar[XB_TOP], 1u);
            const unsigned tg = og / nx;
            if (og + 1u == (tg + 1u) * nx) xb_add(&bar[XB_TOPGEN], 1u);
            else XB_SPIN(xb_ld(&bar[XB_TOPGEN]) == tg, bar);
            __builtin_amdgcn_fence(__ATOMIC_ACQUIRE, "agent");
            xb_add(&bar[XB_XGEN(b.x)], 1u);
            asm volatile("s_waitcnt vmcnt(0)" ::: "memory");
        } else {
            XB_SPIN(xb_ld(&bar[XB_XGEN(b.x)]) == gen, bar);
            __builtin_amdgcn_fence(__ATOMIC_ACQUIRE, "agent");
            asm volatile("s_waitcnt vmcnt(0)" ::: "memory");
        }
    }
    __syncthreads();
}


typedef _Float16 h16x4 __attribute__((ext_vector_type(4)));
struct EpiResLN {
    static constexpr bool PERM = false, AFTER_DRAIN = true;
    const float* base32; const _Float16* base16; float alpha; const float* g; const float* b; float* out32; _Float16* xh; bf16_t* xb; unsigned long long* stats; unsigned* cnt; unsigned need; unsigned* tmo;
    __device__ __forceinline__ void fused(pg8::f32x4 (&acc)[2][2][4][2], const pg8::Unit& u, int wr, int wc, int fr, int fq, LAS unsigned char* lds, int wid, int lane) const {
        typedef float f32x2v __attribute__((ext_vector_type(2)));
        LAS f32x2v* P = (LAS f32x2v*)lds;
        LAS f32x2v* ST = (LAS f32x2v*)(lds + 8192);
        const int row0 = u.pm * 256 + wr * 64 + fr, col0 = u.pn * 256 + wc * 32 + 4 * fq;
#pragma unroll
        for (int ai = 0; ai < 2; ++ai)
#pragma unroll
            for (int m = 0; m < 4; ++m) {
                const size_t off = (size_t)(row0 + ai * 128 + m * 16) * DM + col0;
                float s = 0.f, q = 0.f;
#pragma unroll
                for (int bj = 0; bj < 2; ++bj)
#pragma unroll
                    for (int n = 0; n < 2; ++n) { f32x4 bs;
                        if (base32) bs = *(const f32x4*)(base32 + off + bj * 128 + n * 16);
                        else bs = __builtin_convertvector(*(const h16x4*)(base16 + off + bj * 128 + n * 16), f32x4);
                        const f32x4 v = bs * alpha + acc[ai][bj][m][n]; acc[ai][bj][m][n] = v;
                        s += (v[0] + v[1]) + (v[2] + v[3]); q += (v[0] * v[0] + v[1] * v[1]) + (v[2] * v[2] + v[3] * v[3]); }
                s = rsum32(rsum16(s)); q = rsum32(rsum16(q));
                if (fq == 0) P[(ai * 128 + wr * 64 + m * 16 + fr) * 4 + wc] = (f32x2v){s, q};
                asm volatile("" ::: "memory");
            }
        __syncthreads();
        const int tid = wid * 64 + lane;
        if (tid < 256) {
            const f32x2v a = P[tid * 4 + 0], b2 = P[tid * 4 + 1], c = P[tid * 4 + 2], d = P[tid * 4 + 3];
            const float S = (a.x + b2.x) + (c.x + d.x), Q = (a.y + b2.y) + (c.y + d.y);
            __hip_atomic_store(stats + ((size_t)(u.pm * 256 + tid) * 8 + u.pn), ((unsigned long long)__float_as_uint(Q) << 32) | __float_as_uint(S), __ATOMIC_RELAXED, __HIP_MEMORY_SCOPE_AGENT);
        }
        asm volatile("s_waitcnt vmcnt(0)" ::: "memory");
        __syncthreads();
        if (tid == 0) {
            __hip_atomic_fetch_add(cnt + 64 * u.pm, 1u, __ATOMIC_RELAXED, __HIP_MEMORY_SCOPE_AGENT);
            unsigned sp = 0;
            while (__hip_atomic_load(cnt + 64 * u.pm, __ATOMIC_RELAXED, __HIP_MEMORY_SCOPE_AGENT) < need) {
                __builtin_amdgcn_s_sleep(1);
                if (++sp > (1u << 22)) { __hip_atomic_store(tmo, 1u, __ATOMIC_RELAXED, __HIP_MEMORY_SCOPE_AGENT); break; }
            }
        }
        __syncthreads();
        if (tid < 256) {
            const unsigned long long* sp = stats + (size_t)(u.pm * 256 + tid) * 8;
            float S = 0.f, Q = 0.f;
#pragma unroll
            for (int t = 0; t < 8; ++t) { const unsigned long long w = __hip_atomic_load(sp + t, __ATOMIC_RELAXED, __HIP_MEMORY_SCOPE_AGENT); S += __uint_as_float((unsigned)w); Q += __uint_as_float((unsigned)(w >> 32)); }
            const float mean = S * (1.0f / DM), var = Q * (1.0f / DM) - mean * mean;
            ST[tid] = (f32x2v){mean, rsqrtf(fmaxf(var, 0.f) + 1e-5f)};
        }
        __syncthreads();
#pragma unroll
        for (int bj = 0; bj < 2; ++bj)
#pragma unroll
            for (int n = 0; n < 2; ++n) {
                const f32x4 gg = *(const f32x4*)(g + col0 + bj * 128 + n * 16), bb = *(const f32x4*)(b + col0 + bj * 128 + n * 16);
#pragma unroll
                for (int ai = 0; ai < 2; ++ai)
#pragma unroll
                    for (int m = 0; m < 4; ++m) {
                        const f32x2v sr = ST[ai * 128 + wr * 64 + m * 16 + fr];
                        const size_t off = (size_t)(row0 + ai * 128 + m * 16) * DM + col0 + bj * 128 + n * 16;
                        const f32x4 o = (acc[ai][bj][m][n] - sr.x) * sr.y * gg + bb;
                        if (out32) *(f32x4*)(out32 + off) = o;
                        else { *(h16x4*)(xh + off) = __builtin_convertvector(o, h16x4);
                               u32x2 w; w.x = pk2(o[0], o[1]); w.y = pk2(o[2], o[3]); *(u32x2*)(xb + off) = w; }
                    }
            }
    }
};

struct EpiMlaDown {
    static constexpr bool PERM = true, AFTER_DRAIN = false;
    bf16_t* cq; bf16_t* ckv; float* kr32; float* part;
    __device__ __forceinline__ void operator()(const pg8::f32x4 (&acc)[2][2][4][2], const pg8::Unit& u, int wr, int wc, int fr, int fq) const {
        const int row0 = u.pm * 256 + wr * 64 + fr;
        if (u.pn < 4) {
            bf16_t* dst = (u.pn < 2 ? cq : ckv) + (u.pn & 1) * 256 + wc * 32 + 8 * fq;
#pragma unroll
            for (int ai = 0; ai < 2; ++ai)
#pragma unroll
                for (int m = 0; m < 4; ++m) { const int row = row0 + ai * 128 + m * 16; float q = 0.f;
#pragma unroll
                    for (int bj = 0; bj < 2; ++bj) { const f32x4 v0 = acc[ai][bj][m][0], v1 = acc[ai][bj][m][1];
                        q += (v0[0] * v0[0] + v0[1] * v0[1]) + (v0[2] * v0[2] + v0[3] * v0[3]) + (v1[0] * v1[0] + v1[1] * v1[1]) + (v1[2] * v1[2] + v1[3] * v1[3]);
                        u32x4 w; w.x = pk2(v0[0], v0[1]); w.y = pk2(v0[2], v0[3]); w.z = pk2(v1[0], v1[1]); w.w = pk2(v1[2], v1[3]);
                        *(u32x4*)(dst + (size_t)row * 512 + bj * 128) = w; }
                    q = rsum32(rsum16(q));
                    if (fq == 0) part[(size_t)row * 16 + u.pn * 4 + wc] = q; }
        } else if (wc < 2) {
#pragma unroll
            for (int ai = 0; ai < 2; ++ai)
#pragma unroll
                for (int m = 0; m < 4; ++m) { float* rp = kr32 + (size_t)(row0 + ai * 128 + m * 16) * 64 + wc * 32 + 8 * fq;
                    *(f32x4*)rp = acc[ai][0][m][0]; *(f32x4*)(rp + 4) = acc[ai][0][m][1]; }
        }
    }
};
struct EpiBf16RowScale {
    static constexpr bool PERM = true, AFTER_DRAIN = false;
    bf16_t* O; int ldc; const float* part; int sel;
    __device__ __forceinline__ void operator()(const pg8::f32x4 (&acc)[2][2][4][2], const pg8::Unit& u, int wr, int wc, int fr, int fq) const {
        const int row0 = u.pm * 256 + wr * 64 + fr; const int col0 = u.pn * 256 + wc * 32 + 8 * fq;
#pragma unroll
        for (int ai = 0; ai < 2; ++ai)
#pragma unroll
            for (int m = 0; m < 4; ++m) { const int row = row0 + ai * 128 + m * 16;
                const f32x4 a = *(const f32x4*)(part + (size_t)row * 16 + sel * 8), b = *(const f32x4*)(part + (size_t)row * 16 + sel * 8 + 4);
                const float r = rsqrtf((((a[0] + a[1]) + (a[2] + a[3])) + ((b[0] + b[1]) + (b[2] + b[3]))) * (1.0f / 512.0f) + 1e-6f);
                bf16_t* rowp = O + (size_t)row * ldc + col0;
#pragma unroll
                for (int bj = 0; bj < 2; ++bj) { const f32x4 v0 = acc[ai][bj][m][0] * r, v1 = acc[ai][bj][m][1] * r;
                    u32x4 w; w.x = pk2(v0[0], v0[1]); w.y = pk2(v0[2], v0[3]); w.z = pk2(v1[0], v1[1]); w.w = pk2(v1[2], v1[3]);
                    *(u32x4*)(rowp + bj * 128) = w; } }
    }
};
__device__ __forceinline__ void mla_krope_step(const Params& p) {
    const int tid = ltid();
    for (int i = blockIdx.x * 512 + tid; i < NTOK * 32; i += gridDim.x * 512) {
        const int row = i >> 5, f = i & 31, s = row % SEQ;
        const float t1 = p.kr32[(size_t)row * 64 + f], t2 = p.kr32[(size_t)row * 64 + 32 + f];
        const float c = p.rope[s * 64 + f], sn = p.rope[s * 64 + 32 + f];
        p.krope[(size_t)row * 64 + f] = f2bf(t1 * c - t2 * sn); p.krope[(size_t)row * 64 + 32 + f] = f2bf(t1 * sn + t2 * c);
    }
}

template <class Epi>
__device__ __forceinline__ void run_gemm(LAS unsigned char* lds, const bf16_t* A, const bf16_t* Bt, int N, int K, const Epi& E) {
    pg8::Gemm g{A, Bt, NTOK, N, K}; pg8::StaticOrder S; S.init(NTOK, N, (int)gridDim.x, (int)blockIdx.x);
    pg8::gemm_phase<Epi, pg8::StaticOrder, false>(lds, g, S, E, nullptr);
    __syncthreads();
}

__global__ void __launch_bounds__(512) mega(Params p_unused) {
    extern __shared__ __attribute__((aligned(16))) unsigned char lds_raw[];
    LAS unsigned char* lds = (LAS unsigned char*)lds_raw;
    cg::grid_group grid = cg::this_grid();
    KP kp = (KP)__builtin_amdgcn_kernarg_segment_ptr();
    volatile LAS unsigned* stw = (volatile LAS unsigned*)(lds + 131072);
    {
        const Params& p = PK(kp);
        if (blockIdx.x == 0) for (int i = ltid(); i < XCD_BAR_WORDS; i += 512) p.bar[i] = 0u;
        if (blockIdx.x == 1) for (int i = ltid(); i < 32 * 64 + 64; i += 512) p.pcnt[i] = 0u;
        if (ltid() < 4) stw[ltid()] = 0u;
    }
    phase0(PK(kp), lds);
    grid.sync();
    XcdBarrier xbar = xcd_barrier_post(PK(kp).bar, stw);
#pragma unroll 1
    for (int L = 0; L < 4; ++L) {
        {
            const Params& p = PK(kp);
            const bf16_t* win = (L == 0) ? p.w_moba_qkv : (L == 1) ? p.w_swa_qkv : p.w_nsa_in;
            const int nin = (L == 0) ? MOBA_LD : (L == 1) ? SWA_LD : NSA_LD;
            if (L != 3) run_gemm(lds, p.xb, win, nin, DM, pg8::EpiBf16{p.proj, nin});
            else run_gemm(lds, p.xb, p.w_mla_down, MLA_DN_LD, DM, EpiMlaDown{p.cqn, p.ckvn, p.kr32, p.part});
        }
        xcd_barrier(xbar);
        if (L == 0) {
            moba_kmean_phase(PK(kp), lds);
            xcd_barrier(xbar);
            moba_attn_phase(PK(kp), lds);
        } else if (L == 1) {
            swa_attn_phase(PK(kp), lds);
        } else if (L == 2) {
            nsa_cmp1_phase(PK(kp), lds);
            xcd_barrier(xbar);
            nsa_cmp2_phase(PK(kp));
            xcd_barrier(xbar);
            nsa_attn_phase(PK(kp), lds);
        } else {
            mla_krope_step(PK(kp));
#pragma unroll 1
            for (int i = 0; i < 2; ++i) {
                const Params& p = PK(kp);
                run_gemm(lds, i ? p.ckvn : p.cqn, i ? p.w_mla_ukv : p.w_mla_uq, i ? MLA_KV_LD : MLA_Q_LD, 512,
                         EpiBf16RowScale{p.proj + (i ? (size_t)NTOK * MLA_Q_LD : 0), i ? MLA_KV_LD : MLA_Q_LD, p.part, i});
            }
            xcd_barrier(xbar);
            mla_attn_phase(PK(kp), lds);
        }
        xcd_barrier(xbar);
        {
            const Params& p = PK(kp);
            const bf16_t* wo = (L == 0) ? p.w_moba_o : (L == 1) ? p.w_swa_o : (L == 2) ? p.w_nsa_o : p.w_mla_o;
            if (L == 0) run_gemm(lds, p.att, wo, DM, DM, EpiResLN{p.x, nullptr, ALPHA_F, p.ln1_g, p.ln1_b, nullptr, p.xh, p.xb, p.stats, p.pcnt, 8u, p.pcnt + 32 * 64});
            else run_gemm(lds, p.att, wo, DM, DM, EpiResLN{nullptr, p.xh, ALPHA_F, p.ln1_g + L * DM, p.ln1_b + L * DM, nullptr, p.xh, p.xb, p.stats, p.pcnt, 8u * (unsigned)(2 * L + 1), p.pcnt + 32 * 64});
        }
        xcd_barrier(xbar);
        { const Params& p = PK(kp); run_gemm(lds, p.xb, p.w_gu + (size_t)L * 2 * DFF * DM, 2 * DFF, DM, pg8::EpiSwiGLU{p.hid, DFF}); }
        xcd_barrier(xbar);
        { const Params& p = PK(kp); run_gemm(lds, p.hid, p.w_dn + (size_t)L * DM * DFF, DM, DFF,
                                             EpiResLN{nullptr, p.xh, ALPHA_F, p.ln2_g + L * DM, p.ln2_b + L * DM, (L == 3) ? p.out : nullptr, p.xh, p.xb, p.stats, p.pcnt, 8u * (unsigned)(2 * L + 2), p.pcnt + 32 * 64}); }
        if (L < 3) xcd_barrier(xbar);
    }
}

extern "C" void kernel_launch(void* const* d_in, const int* in_sizes, int n_in, void* d_out, int out_size, void* d_ws, size_t ws_size, hipStream_t stream) {
    (void)in_sizes; (void)n_in; (void)out_size;
    static int grid_blocks = 0;
    if (!grid_blocks) {
        int dev = 0, cus = 0, per_cu = 0;
        hipGetDevice(&dev);
        hipDeviceGetAttribute(&cus, hipDeviceAttributeMultiprocessorCount, dev);
        hipFuncSetAttribute((const void*)mega, hipFuncAttributeMaxDynamicSharedMemorySize, LDS_BYTES);
        hipOccupancyMaxActiveBlocksPerMultiprocessor(&per_cu, (const void*)mega, 512, LDS_BYTES);
        if (per_cu < 1) per_cu = 1;
        grid_blocks = cus * 1;
        (void)hipGetLastError();
    }
    const float* const* in = (const float* const*)d_in;
    Params p{};
    p.x = in[0]; p.rel_bias = in[1]; p.swa_sinks = in[5]; p.cmp_pos = in[8]; p.cmp_w1 = in[9];
    p.q_norm = in[13]; p.kv_norm = in[14];
    p.ln1_g = in[18]; p.ln1_b = in[19]; p.ln2_g = in[23]; p.ln2_b = in[24];
    p.out = (float*)d_out;
    unsigned char* ws = (unsigned char*)d_ws; size_t off = 0;
    auto take = [&](size_t bytes) { unsigned char* r = ws + off; off += (bytes + 255) & ~(size_t)255; return r; };
    int nj = 0, tiles = 0;
    auto job = [&](const float* src, int K, int N, int Npad, int blk, int stride, int offr, bf16_t* dst) {
        CvtJob& j = p.jobs[nj++]; j.src = src; j.dst = dst; j.K = K; j.N = N; j.Npad = Npad; j.blk = blk; j.stride = stride; j.off = offr; j.tile0 = tiles; j.pad = 0; j.kscale = nullptr;
        tiles += ((K + 511) / 512) * (Npad / 64);
    };
    auto plain = [&](const float* src, int K, int N, int Npad) { bf16_t* d = (bf16_t*)take((size_t)Npad * K * 2); job(src, K, N, Npad, Npad, Npad, 0, d); return (const bf16_t*)d; };
    p.w_moba_qkv = plain(in[2], DM, 6144, 6144);
    p.w_moba_o = plain(in[3], DM, DM, DM);
    p.w_swa_qkv = plain(in[4], DM, 2560, 2560);
    p.w_swa_o = plain(in[6], DM, DM, DM);
    p.w_nsa_in = plain(in[7], DM, 5168, NSA_LD);
    p.w_nsa_o = plain(in[11], DM, DM, DM);
    { bf16_t* d = (bf16_t*)take((size_t)2 * 256 * 4096 * 2); p.w_cmp1 = d;
      for (int kv = 0; kv < 2; ++kv) job(in[9] + (size_t)kv * 4096 * 256, 4096, 256, 256, 256, 256, 0, d + (size_t)kv * 256 * 4096); }
    { bf16_t* d = (bf16_t*)take((size_t)2 * 128 * 256 * 2); p.w_cmp2 = d;
      for (int kv = 0; kv < 2; ++kv) job(in[10] + (size_t)kv * 256 * 128, 256, 128, 128, 128, 128, 0, d + (size_t)kv * 128 * 256); }
    p.w_mla_down = plain(in[12], DM, 1088, MLA_DN_LD);
    p.w_mla_uq = plain(in[15], 512, 3072, 3072); p.jobs[nj - 1].kscale = in[13];
    p.w_mla_ukv = plain(in[16], 512, 4096, 4096); p.jobs[nj - 1].kscale = in[14];
    p.w_mla_o = plain(in[17], DM, DM, DM);
    { bf16_t* d = (bf16_t*)take((size_t)4 * 2 * DFF * DM * 2); p.w_gu = d;
      for (int L = 0; L < 4; ++L) { job(in[20] + (size_t)L * DM * DFF, DM, DFF, DFF, 128, 256, 0, d + (size_t)L * 2 * DFF * DM); job(in[21] + (size_t)L * DM * DFF, DM, DFF, DFF, 128, 256, 128, d + (size_t)L * 2 * DFF * DM); } }
    { bf16_t* d = (bf16_t*)take((size_t)4 * DM * DFF * 2); p.w_dn = d;
      for (int L = 0; L < 4; ++L) job(in[22] + (size_t)L * DFF * DM, DFF, DM, DM, DM, DM, 0, d + (size_t)L * DM * DFF); }
    p.njobs = nj; p.total_tiles = tiles;
    p.xb = (bf16_t*)take((size_t)NTOK * DM * 2);
    p.xh = (_Float16*)take((size_t)NTOK * DM * 2);
    p.y = (float*)take((size_t)NTOK * DM * 4);
    p.cdown = p.y; p.kr32 = p.y; p.part = p.y + (size_t)NTOK * 64;
    p.proj = (bf16_t*)take((size_t)NTOK * 7168 * 2);
    p.hid = p.proj;
    p.att = (bf16_t*)take((size_t)NTOK * DM * 2);
    p.cqn = p.att; p.ckvn = p.att + (size_t)NTOK * 512;
    p.kmean = (float*)take((size_t)NB * NHEAD * 8 * 128 * 4);
    p.pe_b16 = (bf16_t*)take(2 * 4096 * 2);
    p.rope = (float*)take((size_t)SEQ * 64 * 4);
    p.cmp_hid = (bf16_t*)take((size_t)32 * 128 * 256 * 2);
    p.kcvc = (bf16_t*)take((size_t)32 * 128 * 128 * 2);
    p.krope = (bf16_t*)take((size_t)NTOK * 64 * 2);
    p.bar = (unsigned*)take((size_t)XCD_BAR_WORDS * 4);
    p.stats = (unsigned long long*)take((size_t)NTOK * 8 * 8);
    p.pcnt = (unsigned*)take((size_t)(32 * 64 + 64) * 4);
    if (off > ws_size || nj > NJOBS) { fprintf(stderr, "kernel_launch: workspace too small (%zu > %zu) or jobs %d\n", off, ws_size, nj); return; }
    void* args[] = {&p};
    hipError_t e = hipLaunchCooperativeKernel((const void*)mega, dim3(grid_blocks), dim3(512), args, LDS_BYTES, stream);
    if (e != hipSuccess) fprintf(stderr, "cooperative launch failed: %s (grid %d)\n", hipGetErrorString(e), grid_blocks);
}
```

```cpp
#include <hip/hip_runtime.h>
#include <hip/hip_cooperative_groups.h>
#include <cstdio>
namespace cg = cooperative_groups;
namespace pg8 {
#define PG8_LAS __attribute__((address_space(3)))
typedef unsigned short bf16_t;
typedef short bf16x8 __attribute__((ext_vector_type(8)));
typedef float f32x4 __attribute__((ext_vector_type(4)));
typedef unsigned u32x4 __attribute__((ext_vector_type(4)));
constexpr int BM = 256, BK = 64, HALF = 128, HTB = HALF * BK * 2  , STAGE_BYTES = 8 * HTB, NXCD = 8, WGM = 8;

__host__ __device__ __forceinline__ int lds_byte(int r, int c) { const int st = (r >> 4) * 2 + (c >> 5), rr = r & 15, cc = c & 31, ob = rr * 64 + cc * 2; return st * 1024 + (ob ^ (((ob >> 9) & 1) << 5)); }
__host__ __device__ __forceinline__ void stage_rc(int b, int& R, int& C) { const int st = b / 1024, sb = b % 1024, swz = sb ^ (((sb >> 9) & 1) << 5); R = (st >> 1) * 16 + swz / 64; C = (st & 1) * 32 + (swz % 64) / 2; }
__host__ __device__ __forceinline__ int perm32(int rho) { const int n = rho >> 4, i = rho & 15; return 8 * (i >> 2) + 4 * n + (i & 3); }

struct Unit { int pm, pn; };
struct Gemm { const bf16_t* A; const bf16_t* Bt; int M, N, K; };

struct StaticOrder {
    int nM, nN, nwg, G, c;
    __host__ __device__ void init(int M, int N, int G_, int c_) { nM = M / BM; nN = N / BM; nwg = nM * nN; G = G_; c = c_; }
    __host__ __device__ bool next(int i, Unit& u) const {
        const long L = (long)i * G + c; if (L >= nwg) return false;
        int wgid = (int)L; { const int q = nwg / NXCD, r = nwg % NXCD, xcd = wgid % NXCD, off = wgid / NXCD; wgid = (xcd < r ? xcd * (q + 1) : r * (q + 1) + (xcd - r) * q) + off; }
        const int nig = WGM * nN, gid = wgid / nig, fm = gid * WGM, gsz = (nM - fm) < WGM ? (nM - fm) : WGM;
        u.pm = fm + ((wgid % nig) % gsz); u.pn = (wgid % nig) / gsz; return true;
    }
    __device__ __forceinline__ void a_ready(const Unit&) const {}
    __device__ __forceinline__ void done(const Unit&) const {}
};
__device__ __forceinline__ unsigned cvt_pk_bf16(float lo, float hi) { unsigned r; asm volatile("v_cvt_pk_bf16_f32 %0, %1, %2" : "=v"(r) : "v"(lo), "v"(hi)); return r; }
typedef float f32x2 __attribute__((ext_vector_type(2)));
struct EpiF32 {
    static constexpr bool PERM = false, AFTER_DRAIN = false;
    float* C; int ldc;
    __device__ __forceinline__ void operator()(const f32x4 (&acc)[2][2][4][2], const Unit& u, int wr, int wc, int fr, int fq) const {
        const int row0 = u.pm * BM + wr * 64 + fr, col0 = u.pn * BM + wc * 32 + 4 * fq;
#pragma unroll
        for (int ai = 0; ai < 2; ++ai)
#pragma unroll
            for (int m = 0; m < 4; ++m) { float* rowp = C + (size_t)(row0 + ai * HALF + m * 16) * ldc + col0;
#pragma unroll
                for (int bj = 0; bj < 2; ++bj)
#pragma unroll
                    for (int n = 0; n < 2; ++n) *(f32x4*)(rowp + bj * HALF + n * 16) = acc[ai][bj][m][n]; }
    }
};
struct EpiRes {
    static constexpr bool PERM = false, AFTER_DRAIN = false;
    float* C; const float* base; int ldc; float alpha;
    __device__ __forceinline__ void operator()(const f32x4 (&acc)[2][2][4][2], const Unit& u, int wr, int wc, int fr, int fq) const {
        const int row0 = u.pm * BM + wr * 64 + fr, col0 = u.pn * BM + wc * 32 + 4 * fq;
#pragma unroll
        for (int ai = 0; ai < 2; ++ai)
#pragma unroll
            for (int m = 0; m < 4; ++m) { const size_t off = (size_t)(row0 + ai * HALF + m * 16) * ldc + col0;
#pragma unroll
                for (int bj = 0; bj < 2; ++bj)
#pragma unroll
                    for (int n = 0; n < 2; ++n) { const f32x4 b = *(const f32x4*)(base + off + bj * HALF + n * 16);
                        *(f32x4*)(C + off + bj * HALF + n * 16) = b * alpha + acc[ai][bj][m][n]; } }
    }
};
struct EpiBf16 {
    static constexpr bool PERM = true, AFTER_DRAIN = false;
    bf16_t* O; int ldc;
    __device__ __forceinline__ void operator()(const f32x4 (&acc)[2][2][4][2], const Unit& u, int wr, int wc, int fr, int fq) const {
        const int row0 = u.pm * BM + wr * 64 + fr; const int col0 = u.pn * BM + wc * 32 + 8 * fq;
#pragma unroll
        for (int ai = 0; ai < 2; ++ai)
#pragma unroll
            for (int m = 0; m < 4; ++m) { bf16_t* rowp = O + (size_t)(row0 + ai * HALF + m * 16) * ldc + col0;
#pragma unroll
                for (int bj = 0; bj < 2; ++bj) { const f32x4 v0 = acc[ai][bj][m][0], v1 = acc[ai][bj][m][1];
                    u32x4 w; w.x = cvt_pk_bf16(v0[0], v0[1]); w.y = cvt_pk_bf16(v0[2], v0[3]); w.z = cvt_pk_bf16(v1[0], v1[1]); w.w = cvt_pk_bf16(v1[2], v1[3]);
                    *(u32x4*)(rowp + bj * HALF) = w; } }
    }
};
__device__ __forceinline__ float silu_f(float x) { return x * __builtin_amdgcn_rcpf(1.0f + __builtin_amdgcn_exp2f(x * -1.4426950408889634f)); }
struct EpiSwiGLU {
    static constexpr bool PERM = true, AFTER_DRAIN = false;
    bf16_t* H; int ldc;
    __device__ __forceinline__ void operator()(const f32x4 (&acc)[2][2][4][2], const Unit& u, int wr, int wc, int fr, int fq) const {
        const int row0 = u.pm * BM + wr * 64 + fr; const int col0 = u.pn * HALF + wc * 32 + 8 * fq;
#pragma unroll
        for (int ai = 0; ai < 2; ++ai)
#pragma unroll
            for (int m = 0; m < 4; ++m) { bf16_t* rowp = H + (size_t)(row0 + ai * HALF + m * 16) * ldc + col0;
                f32x4 h0, h1;
#pragma unroll
                for (int j = 0; j < 4; ++j) { h0[j] = silu_f(acc[ai][0][m][0][j]) * acc[ai][1][m][0][j]; h1[j] = silu_f(acc[ai][0][m][1][j]) * acc[ai][1][m][1][j]; }
                u32x4 w; w.x = cvt_pk_bf16(h0[0], h0[1]); w.y = cvt_pk_bf16(h0[2], h0[3]); w.z = cvt_pk_bf16(h1[0], h1[1]); w.w = cvt_pk_bf16(h1[2], h1[3]);
                *(u32x4*)rowp = w; }
    }
};

template <class Epi, class Sched, bool STAMP = false>
__device__ __forceinline__ void gemm_phase(PG8_LAS unsigned char* lds, const Gemm g, const Sched& S, const Epi& E, unsigned long long* stamps) {
    int tid_l = threadIdx.x; asm volatile("" : "+v"(tid_l)); const int tid = tid_l, wid = __builtin_amdgcn_readfirstlane(tid >> 6), lane = tid & 63, wr = wid >> 2, wc = wid & 3, fr = lane & 15, fq = lane >> 4;
    const int K = g.K, nt = K / BK;
    int ts_lo = 0, ts_hi = 0, nts = 0; const unsigned long long rt_entry = STAMP ? (unsigned long long)wall_clock64() : 0ull;
#define PG8_STAMP() do { if (STAMP && wid == 0 && nts < 64) { const unsigned long long _c = (unsigned long long)clock64(); \
        ts_lo = (lane == nts) ? (int)(unsigned)_c : ts_lo; ts_hi = (lane == nts) ? (int)(unsigned)(_c >> 32) : ts_hi; ++nts; } } while (0)
    PG8_STAMP();
    unsigned voffA[2], voffB[2];
#pragma unroll
    for (int i = 0; i < 2; ++i) { int R, C; stage_rc(tid * 16 + i * 8192, R, C); const int Rb = Epi::PERM ? ((R & ~31) + perm32(R & 31)) : R;
        voffA[i] = (unsigned)(R * K + C) * 2u; voffB[i] = (unsigned)(Rb * K + C) * 2u; }
    const size_t kstep = (size_t)(BK * 2);
    const size_t hstep = (size_t)HALF * K * 2;
    const size_t tstep = 2 * hstep;
    const unsigned ldsw = (unsigned)wid * 1024u;
    const int aoff = lds_byte(wr * 64 + fr, fq * 8), boff = lds_byte(wc * 32 + fr, fq * 8);
#define PG8_SA(b, h) (((b) * 2 + (h)) * HTB)
#define PG8_SB(b, h) ((4 + (b) * 2 + (h)) * HTB)
#define PG8_STAGE(bufoff, gbase, voff) do { _Pragma("unroll") for (int _i = 0; _i < 2; ++_i) \
        __builtin_amdgcn_global_load_lds((const unsigned*)((const char*)(gbase) + (voff)[_i]), (PG8_LAS unsigned*)(lds + (bufoff) + ldsw + _i * 8192), 16, 0, 0); } while (0)
#define PG8_LDA(dst, b, h) do { _Pragma("unroll") for (int m = 0; m < 4; ++m) _Pragma("unroll") for (int k = 0; k < 2; ++k) dst[m][k] = *(const PG8_LAS bf16x8*)(lds + PG8_SA(b, h) + aoff + m * 2048 + k * 1024); } while (0)
#define PG8_LDB(dst, b, h) do { _Pragma("unroll") for (int n = 0; n < 2; ++n) _Pragma("unroll") for (int k = 0; k < 2; ++k) dst[n][k] = *(const PG8_LAS bf16x8*)(lds + PG8_SB(b, h) + boff + n * 2048 + k * 1024); } while (0)
#define PG8_MMA(ai, bj, At, Bt) do { __builtin_amdgcn_s_setprio(1); _Pragma("unroll") for (int m = 0; m < 4; ++m) _Pragma("unroll") for (int n = 0; n < 2; ++n) _Pragma("unroll") for (int k = 0; k < 2; ++k) \
        acc[ai][bj][m][n] = __builtin_amdgcn_mfma_f32_16x16x32_bf16(Bt[n][k], At[m][k], acc[ai][bj][m][n], 0, 0, 0); __builtin_amdgcn_s_setprio(0); } while (0)
#define PG8_WAIT_V(n) asm volatile("s_waitcnt vmcnt(" #n ")" ::: "memory")
#define PG8_WAIT_L(n) asm volatile("s_waitcnt lgkmcnt(" #n ")" ::: "memory")
#define PG8_BAR __builtin_amdgcn_s_barrier()
#define PG8_SCHED __builtin_amdgcn_sched_barrier(0)
    Unit cur, nxt; int ui = 0;
    if (!S.next(0, cur)) return;
    f32x4 acc[2][2][4][2];
#pragma unroll
    for (int a = 0; a < 2; ++a)
#pragma unroll
        for (int b = 0; b < 2; ++b)
#pragma unroll
            for (int m = 0; m < 4; ++m)
#pragma unroll
                for (int n = 0; n < 2; ++n) acc[a][b][m][n] = (f32x4){0.f, 0.f, 0.f, 0.f};
    bf16x8 At[4][2], B0[2][2], B1[2][2];
    const char* cA = (const char*)g.A + (size_t)cur.pm * tstep; const char* cB = (const char*)g.Bt + (size_t)cur.pn * tstep;
    S.a_ready(cur);
    PG8_STAGE(PG8_SB(0, 0), cB, voffB); PG8_STAGE(PG8_SA(0, 0), cA, voffA); PG8_STAGE(PG8_SB(0, 1), cB + hstep, voffB); PG8_STAGE(PG8_SA(0, 1), cA + hstep, voffA);
    if (wr == 1) PG8_BAR;
    PG8_WAIT_V(4); PG8_BAR;
    PG8_STAGE(PG8_SB(1, 0), cB + kstep, voffB); PG8_STAGE(PG8_SA(1, 0), cA + kstep, voffA); PG8_STAGE(PG8_SB(1, 1), cB + hstep + kstep, voffB);
    PG8_WAIT_V(6); PG8_BAR;
    PG8_STAMP();
    for (;;) {
        const bool has_next = S.next(ui + 1, nxt);
        const char* nA = has_next ? (const char*)g.A + (size_t)nxt.pm * tstep : cA; const char* nB = has_next ? (const char*)g.Bt + (size_t)nxt.pn * tstep : cB;
        for (int t = 0; t < nt; t += 2) {
            const bool last = (t == nt - 2);
            const char* a1 = cA + (size_t)(t + 1) * kstep;
            const char* a2 = last ? nA : cA + (size_t)(t + 2) * kstep; const char* b2 = last ? nB : cB + (size_t)(t + 2) * kstep;
            const char* a3 = a2 + kstep; const char* b3 = b2 + kstep;
            if (last && has_next) S.a_ready(nxt);
            PG8_LDB(B0, 0, 0); PG8_SCHED; PG8_LDA(At, 0, 0); PG8_STAGE(PG8_SA(1, 1), a1 + hstep, voffA);
            PG8_WAIT_L(8); PG8_BAR; PG8_WAIT_L(0); PG8_MMA(0, 0, At, B0); PG8_BAR; PG8_SCHED;
            PG8_LDB(B1, 0, 1); PG8_STAGE(PG8_SB(0, 0), b2, voffB);
            PG8_BAR; PG8_WAIT_L(0); PG8_MMA(0, 1, At, B1); PG8_BAR;
            PG8_LDA(At, 0, 1); PG8_STAGE(PG8_SA(0, 0), a2, voffA);
            PG8_BAR; PG8_WAIT_L(0); PG8_MMA(1, 0, At, B0); PG8_BAR; PG8_SCHED;
            PG8_STAGE(PG8_SB(0, 1), b2 + hstep, voffB);
            PG8_WAIT_V(6); PG8_BAR; PG8_MMA(1, 1, At, B1); PG8_BAR;
            PG8_LDB(B0, 1, 0); PG8_SCHED; PG8_LDA(At, 1, 0); PG8_STAGE(PG8_SA(0, 1), a2 + hstep, voffA);
            PG8_WAIT_L(8); PG8_BAR; PG8_WAIT_L(0); PG8_MMA(0, 0, At, B0); PG8_BAR; PG8_SCHED;
            PG8_LDB(B1, 1, 1); PG8_STAGE(PG8_SB(1, 0), b3, voffB);
            PG8_BAR; PG8_WAIT_L(0); PG8_MMA(0, 1, At, B1); PG8_BAR;
            PG8_LDA(At, 1, 1); PG8_STAGE(PG8_SA(1, 0), a3, voffA);
            PG8_BAR; PG8_WAIT_L(0); PG8_MMA(1, 0, At, B0); PG8_BAR; PG8_SCHED;
            PG8_STAGE(PG8_SB(1, 1), b3 + hstep, voffB);
            PG8_WAIT_V(6); PG8_BAR; PG8_MMA(1, 1, At, B1); PG8_BAR;
        }
        PG8_STAMP();
        if constexpr (!Epi::AFTER_DRAIN) { E(acc, cur, wr, wc, fr, fq); S.done(cur); }
        PG8_STAMP();
        if (!has_next) break;
#pragma unroll
        for (int a = 0; a < 2; ++a)
#pragma unroll
            for (int b = 0; b < 2; ++b)
#pragma unroll
                for (int m = 0; m < 4; ++m)
#pragma unroll
                    for (int n = 0; n < 2; ++n) acc[a][b][m][n] = (f32x4){0.f, 0.f, 0.f, 0.f};
        cur = nxt; cA = nA; cB = nB; ++ui;
    }
    PG8_WAIT_V(0);
    if (wr == 0) PG8_BAR;
    PG8_BAR;
    if constexpr (Epi::AFTER_DRAIN) { E.fused(acc, cur, wr, wc, fr, fq, lds, wid, lane); S.done(cur); }
    PG8_STAMP();
    if (STAMP && wid == 0) { stamps[lane] = lane < nts ? (((unsigned long long)(unsigned)ts_hi << 32) | (unsigned)ts_lo) : 0ull;
        if (lane == 62) stamps[62] = rt_entry; if (lane == 63) stamps[63] = (unsigned long long)wall_clock64(); }
#undef PG8_STAMP
#undef PG8_SA
#undef PG8_SB
#undef PG8_STAGE
#undef PG8_LDA
#undef PG8_LDB
#undef PG8_MMA
#undef PG8_WAIT_V
#undef PG8_WAIT_L
#undef PG8_BAR
#undef PG8_SCHED
}
}

#define LAS __attribute__((address_space(3)))
typedef unsigned short bf16_t;
typedef short s16x8 __attribute__((ext_vector_type(8)));
typedef short s16x4 __attribute__((ext_vector_type(4)));
typedef float f32x4 __attribute__((ext_vector_type(4)));
typedef unsigned u32x4 __attribute__((ext_vector_type(4)));
typedef unsigned u32x2 __attribute__((ext_vector_type(2)));

constexpr int DM = 2048, NB = 4, SEQ = 2048, NTOK = NB * SEQ, DFF = 5632, NHEAD = 16, HD = 128;
constexpr int NSA_LD = 5376, MOBA_LD = 6144, SWA_LD = 2560, MLA_DN_LD = 1280, MLA_Q_LD = 3072, MLA_KV_LD = 4096;
constexpr float ALPHA_F = 1.681792830507429f;
constexpr int LDS_BYTES = 131072 + 16;
constexpr int NJOBS = 26;

struct CvtJob { const float* src; bf16_t* dst; const float* kscale; int K, N, Npad, blk, stride, off, tile0, pad; };
struct Params {
    const float* x; const float* rel_bias; const float* swa_sinks; const float* cmp_pos; const float* cmp_w1;
    const float* q_norm; const float* kv_norm;
    const float* ln1_g; const float* ln1_b; const float* ln2_g; const float* ln2_b;
    float* out;
    const bf16_t* w_moba_qkv; const bf16_t* w_moba_o; const bf16_t* w_swa_qkv; const bf16_t* w_swa_o;
    const bf16_t* w_nsa_in; const bf16_t* w_nsa_o; const bf16_t* w_cmp1; const bf16_t* w_cmp2;
    const bf16_t* w_mla_down; const bf16_t* w_mla_uq; const bf16_t* w_mla_ukv; const bf16_t* w_mla_o;
    const bf16_t* w_gu; const bf16_t* w_dn;
    bf16_t* xb; _Float16* xh; float* y; bf16_t* proj; bf16_t* hid; bf16_t* att;
    float* kmean; bf16_t* pe_b16; float* rope; bf16_t* cmp_hid; bf16_t* kcvc; float* cdown; bf16_t* cqn; bf16_t* ckvn; bf16_t* krope; float* kr32; float* part;
    unsigned* bar; unsigned long long* stats; unsigned* pcnt;
    CvtJob jobs[NJOBS];
    int njobs, total_tiles;
};

typedef const __attribute__((address_space(4))) Params* KP;
__device__ __forceinline__ const Params& PK(KP kp) { asm volatile("" : "+s"(kp)); return *(const Params*)kp; }
__device__ __forceinline__ int ltid() { int t = threadIdx.x; asm volatile("" : "+v"(t)); return t; }
__device__ __forceinline__ float bf2f(bf16_t b) { return __uint_as_float(((unsigned)b) << 16); }
__device__ __forceinline__ bf16_t f2bf(float f) { unsigned u = __float_as_uint(f); u += 0x7FFFu + ((u >> 16) & 1u); return (bf16_t)(u >> 16); }
__device__ __forceinline__ unsigned pk2(float lo, float hi) { unsigned r; asm("v_cvt_pk_bf16_f32 %0, %1, %2" : "=v"(r) : "v"(lo), "v"(hi)); return r; }

__device__ __forceinline__ void phase0(const Params& p, LAS unsigned char* lds) {
    const int tid = ltid();
    for (int t = blockIdx.x; t < p.total_tiles; t += gridDim.x) {
        int ji = 0;
#pragma unroll 1
        for (int j = 1; j < p.njobs; ++j) if (t >= p.jobs[j].tile0) ji = j;
        const CvtJob jb = p.jobs[ji];
        const int lt = t - jb.tile0, ntn = jb.Npad >> 6, tk = lt / ntn, tn = lt % ntn;
        const int gn = tn * 64 + (tid & 63), k0 = tk * 512 + (tid >> 6) * 64;
        if (k0 >= jb.K) continue;
        float v[64];
        if (gn < jb.N) {
            const float* sp = jb.src + (size_t)k0 * jb.N + gn;
#pragma unroll
            for (int i = 0; i < 64; ++i) v[i] = __builtin_nontemporal_load(sp + (size_t)i * jb.N);
        } else {
#pragma unroll
            for (int i = 0; i < 64; ++i) v[i] = 0.f;
        }
        if (jb.kscale) {
#pragma unroll
            for (int i = 0; i < 64; ++i) v[i] *= jb.kscale[k0 + i];
        }
        {
            const int row = (gn / jb.blk) * jb.stride + jb.off + (gn % jb.blk);
            bf16_t* dp = jb.dst + (size_t)row * jb.K + k0;
#pragma unroll
            for (int i = 0; i < 8; ++i) { u32x4 w; w.x = pk2(v[8 * i], v[8 * i + 1]); w.y = pk2(v[8 * i + 2], v[8 * i + 3]); w.z = pk2(v[8 * i + 4], v[8 * i + 5]); w.w = pk2(v[8 * i + 6], v[8 * i + 7]);
                *(u32x4*)(dp + 8 * i) = w; }
        }
    }
    {
        const size_t n8 = (size_t)NTOK * DM / 8;
        for (size_t i = (size_t)blockIdx.x * 512 + tid; i < n8; i += (size_t)gridDim.x * 512) {
            const f32x4 a = *(const f32x4*)(p.x + i * 8), b = *(const f32x4*)(p.x + i * 8 + 4);
            u32x4 w; w.x = pk2(a[0], a[1]); w.y = pk2(a[2], a[3]); w.z = pk2(b[0], b[1]); w.w = pk2(b[2], b[3]);
            *(u32x4*)(p.xb + i * 8) = w;
        }
    }
    for (int i = blockIdx.x * 512 + tid; i < SEQ * 32; i += gridDim.x * 512) {
        const int s = i >> 5, f = i & 31;
        const float inv = exp2f(-(float)(2 * f) * (13.287712379549449f / 64.0f));
        const float ang = (float)s * inv;
        const double a = (double)ang, k = rint(a * 0.15915494309189535);
        const float r = (float)(a - k * 6.283185307179586);
        p.rope[s * 64 + f] = __cosf(r); p.rope[s * 64 + 32 + f] = __sinf(r);
    }
    for (int i = blockIdx.x * 512 + tid; i < 2 * 4096; i += gridDim.x * 512) p.pe_b16[i] = f2bf(p.cmp_pos[i]);
}

__device__ __forceinline__ void ln_phase(const float* y, const float* g, const float* b, float* xf, bf16_t* xb) {
    const int tid = ltid(), lane = tid & 63, wave = tid >> 6;
    for (int row = blockIdx.x * 8 + wave; row < NTOK; row += gridDim.x * 8) {
        const float* yr = y + (size_t)row * DM;
        f32x4 v[8]; float s = 0.f;
#pragma unroll
        for (int i = 0; i < 8; ++i) { v[i] = *(const f32x4*)(yr + i * 256 + lane * 4); s += (v[i][0] + v[i][1]) + (v[i][2] + v[i][3]); }
#pragma unroll
        for (int o = 32; o > 0; o >>= 1) s += __shfl_xor(s, o);
        const float mean = s * (1.0f / DM); float q = 0.f;
#pragma unroll
        for (int i = 0; i < 8; ++i) { const f32x4 d = v[i] - mean; q += (d[0] * d[0] + d[1] * d[1]) + (d[2] * d[2] + d[3] * d[3]); }
#pragma unroll
        for (int o = 32; o > 0; o >>= 1) q += __shfl_xor(q, o);
        const float rstd = rsqrtf(q * (1.0f / DM) + 1e-5f);
#pragma unroll
        for (int i = 0; i < 8; ++i) {
            const int c = i * 256 + lane * 4;
            const f32x4 gg = *(const f32x4*)(g + c), bb = *(const f32x4*)(b + c);
            const f32x4 o = (v[i] - mean) * rstd * gg + bb;
            *(f32x4*)(xf + (size_t)row * DM + c) = o;
            if (xb) { u32x2 w; w.x = pk2(o[0], o[1]); w.y = pk2(o[2], o[3]); *(u32x2*)(xb + (size_t)row * DM + c) = w; }
        }
    }
}

constexpr int A_KB0 = 0, A_KBSZ = 25600, A_VB0 = 51200, A_VBSZ = 18432, A_LUT = 106496, A_LUTS = 132, A_RMASK = 110720, A_UMASK = 111744, A_IMP = 111872, A_IMPF = 120064;
constexpr int VSTR = 288;
constexpr float NEG_BIG = -1e30f;

__device__ __forceinline__ s16x4 vtr(const LAS unsigned char* pp) {
    typedef short v4i16_t __attribute__((ext_vector_type(4)));
    return __builtin_bit_cast(s16x4, __builtin_amdgcn_ds_read_tr16_b64_v4i16((LAS v4i16_t*)pp));
}

__device__ __forceinline__ int t5_bucket_dev(int n) {
    if (n < 16) return n;
    const float nf = (float)n;
    int large = 16 + (int)(logf(nf / 16.0f) / 2.0794415416798357f * 16.0f);
    return large < 31 ? large : 31;
}
__device__ __forceinline__ void build_lut(LAS unsigned char* lds, const float* rel_bias, int h0, int G) {
    LAS float* L = (LAS float*)(lds + A_LUT);
    for (int i = ltid(); i < G * 129; i += 512) { const int g = i / 129, d = i % 129; L[g * A_LUTS + d] = rel_bias[t5_bucket_dev(d) * NHEAD + h0 + g] * 1.4426950408889634f; }
}

template <int DQK>
struct KVSrc { const bf16_t* K; size_t ldk; const bf16_t* K2; size_t ldk2; const bf16_t* V; size_t ldv; int nk; };

template <int DQK>
struct KVPlan { const char* kp; const char* vp; const char* rp; unsigned kstep, vstep, rstep, klo, vlo, rlo; };
template <>
struct KVPlan<128> { const char* kp; const char* vp; unsigned kstep, vstep, klo, vlo; };
__device__ __forceinline__ void kv_plan(const KVSrc<128>& s, KVPlan<128>& pl) {
    const int tid = ltid(), row = tid >> 4, ch = tid & 15;
    pl.kp = (const char*)(s.K + (size_t)row * s.ldk + ch * 8); pl.vp = (const char*)(s.V + (size_t)row * s.ldv + ch * 8);
    pl.kstep = (unsigned)(s.ldk * 64); pl.vstep = (unsigned)(s.ldv * 64);
    pl.klo = (unsigned)(row * 272 + ch * 16); pl.vlo = (unsigned)(row * VSTR + ch * 16);
}
__device__ __forceinline__ void kv_gload(const KVPlan<128>& pl, int jt, u32x4 (&kr)[2], u32x4 (&vr)[2]) {
#pragma unroll
    for (int i = 0; i < 2; ++i) { kr[i] = *(const u32x4*)(pl.kp + (size_t)(2 * jt + i) * pl.kstep); vr[i] = *(const u32x4*)(pl.vp + (size_t)(2 * jt + i) * pl.vstep); }
}
__device__ __forceinline__ void kv_lstore(LAS unsigned char* lds, int kbuf, int vbuf, const KVPlan<128>& pl, const u32x4 (&kr)[2], const u32x4 (&vr)[2]) {
#pragma unroll
    for (int i = 0; i < 2; ++i) { *(LAS u32x4*)(lds + A_KB0 + kbuf * A_KBSZ + pl.klo + i * 32 * 272) = kr[i]; *(LAS u32x4*)(lds + A_VB0 + vbuf * A_VBSZ + pl.vlo + i * 32 * VSTR) = vr[i]; }
}
__device__ __forceinline__ void kv_plan(const KVSrc<192>& s, KVPlan<192>& pl) {
    const int tid = ltid(), row = tid >> 4, ch = tid & 15, rrow = tid >> 3, rch = tid & 7;
    pl.kp = (const char*)(s.K + (size_t)row * s.ldk + ch * 8); pl.vp = (const char*)(s.V + (size_t)row * s.ldv + ch * 8);
    pl.rp = (const char*)(s.K2 + (size_t)rrow * s.ldk2 + rch * 8);
    pl.kstep = (unsigned)(s.ldk * 64); pl.vstep = (unsigned)(s.ldv * 64); pl.rstep = (unsigned)(s.ldk2 * 128);
    pl.klo = (unsigned)(row * 400 + ch * 16); pl.vlo = (unsigned)(row * VSTR + ch * 16); pl.rlo = (unsigned)(rrow * 400 + 256 + rch * 16);
}
__device__ __forceinline__ void kv_gload(const KVPlan<192>& pl, int jt, u32x4 (&kr)[3], u32x4 (&vr)[2]) {
#pragma unroll
    for (int i = 0; i < 2; ++i) { kr[i] = *(const u32x4*)(pl.kp + (size_t)(2 * jt + i) * pl.kstep); vr[i] = *(const u32x4*)(pl.vp + (size_t)(2 * jt + i) * pl.vstep); }
    kr[2] = *(const u32x4*)(pl.rp + (size_t)jt * pl.rstep);
}
__device__ __forceinline__ void kv_lstore(LAS unsigned char* lds, int kbuf, int vbuf, const KVPlan<192>& pl, const u32x4 (&kr)[3], const u32x4 (&vr)[2]) {
#pragma unroll
    for (int i = 0; i < 2; ++i) { *(LAS u32x4*)(lds + A_KB0 + kbuf * A_KBSZ + pl.klo + i * 32 * 400) = kr[i]; *(LAS u32x4*)(lds + A_VB0 + vbuf * A_VBSZ + pl.vlo + i * 32 * VSTR) = vr[i]; }
    *(LAS u32x4*)(lds + A_KB0 + kbuf * A_KBSZ + pl.rlo) = kr[2];
}

struct MaskCfg { int KS, KO, W, bsh, nk; float scale; };

__device__ __forceinline__ float rmax16(float x) { auto r = __builtin_amdgcn_permlane16_swap(__float_as_uint(x), __float_as_uint(x), false, false); return fmaxf(__uint_as_float(r[0]), __uint_as_float(r[1])); }
__device__ __forceinline__ float rmax32(float x) { auto r = __builtin_amdgcn_permlane32_swap(__float_as_uint(x), __float_as_uint(x), false, false); return fmaxf(__uint_as_float(r[0]), __uint_as_float(r[1])); }
__device__ __forceinline__ float rsum16(float x) { auto r = __builtin_amdgcn_permlane16_swap(__float_as_uint(x), __float_as_uint(x), false, false); return __uint_as_float(r[0]) + __uint_as_float(r[1]); }
__device__ __forceinline__ float rsum32(float x) { auto r = __builtin_amdgcn_permlane32_swap(__float_as_uint(x), __float_as_uint(x), false, false); return __uint_as_float(r[0]) + __uint_as_float(r[1]); }
__device__ __forceinline__ int wave_min_i(int v) {
#pragma unroll
    for (int o = 1; o < 64; o <<= 1) { const int t = __shfl_xor(v, o); v = t < v ? t : v; }
    return __builtin_amdgcn_readfirstlane(v);
}
__device__ __forceinline__ int wave_max_i(int v) {
#pragma unroll
    for (int o = 1; o < 64; o <<= 1) { const int t = __shfl_xor(v, o); v = t > v ? t : v; }
    return __builtin_amdgcn_readfirstlane(v);
}

template <int DQK, int QT, bool BIAS>
__device__ __forceinline__ void qk_tile(LAS unsigned char* lds, int buf, int jt, const s16x8 (&Qf)[QT][DQK / 32], f32x4 (&S)[4][QT],
                                        const MaskCfg& mc, const int (&qpos)[QT], const unsigned (&rmask)[QT], int gl, int qlo_w, int qhi_w, const float (&mref)[QT]) {
    constexpr int KSTR = DQK * 2 + 16;
    const int lane = ltid() & 63, fr = lane & 15, g4 = lane >> 4;
    const LAS unsigned char* kb = lds + A_KB0 + buf * A_KBSZ + fr * KSTR + g4 * 16;
    {
        constexpr int NKS = DQK / 32, NF = 4 * NKS;
        __builtin_amdgcn_s_setprio(1);
        s16x8 kf[3];
        kf[0] = *(const LAS s16x8*)(kb);
        kf[1] = *(const LAS s16x8*)(kb + 64);
#pragma unroll
        for (int f = 0; f < NF; ++f) {
            const int kt = f / NKS, ks = f % NKS;
            if (f + 2 < NF) { const int kt2 = (f + 2) / NKS, ks2 = (f + 2) % NKS; kf[(f + 2) % 3] = *(const LAS s16x8*)(kb + kt2 * 16 * KSTR + ks2 * 64); }
            if (ks == 0) {
#pragma unroll
                for (int qt = 0; qt < QT; ++qt) S[kt][qt] = (f32x4){0.f, 0.f, 0.f, 0.f};
            }
#pragma unroll
            for (int qt = 0; qt < QT; ++qt) S[kt][qt] = __builtin_amdgcn_mfma_f32_16x16x32_bf16(kf[f % 3], Qf[qt][ks], S[kt][qt], 0, 0, 0);
        }
        __builtin_amdgcn_sched_group_barrier(0x100, 2, 0);
#pragma unroll
        for (int f = 0; f < NF; ++f) {
            if (f + 2 < NF) __builtin_amdgcn_sched_group_barrier(0x100, 1, 0);
            __builtin_amdgcn_sched_group_barrier(0x008, QT, 0);
        }
        __builtin_amdgcn_s_setprio(0);
    }
    const LAS float* L = (const LAS float*)(lds + A_LUT);
    const int kmin = jt * 64 * mc.KS + mc.KO, kmax = (jt * 64 + 63) * mc.KS + mc.KO;
    const bool slow = (kmax > qlo_w) || (qhi_w - kmin >= mc.W) || (jt * 64 + 63 >= mc.nk) || (BIAS && (qlo_w - kmax < 128));
    if (!slow) {
#pragma unroll
        for (int qt = 0; qt < QT; ++qt) {
            const bool rowok = (rmask[qt] >> ((jt * 64) >> mc.bsh)) & 1u;
            const float a = rowok ? mc.scale : 0.f;
            float c = rowok ? -mref[qt] : NEG_BIG;
            if (BIAS) c = rowok ? L[gl * A_LUTS + 128] - mref[qt] : NEG_BIG;
#pragma unroll
            for (int kt = 0; kt < 4; ++kt)
#pragma unroll
                for (int i = 0; i < 4; ++i) S[kt][qt][i] = __builtin_fmaf(S[kt][qt][i], a, c);
        }
    } else {
        const int j0 = jt * 64 + g4 * 4;
#pragma unroll
        for (int qt = 0; qt < QT; ++qt) {
            const int d0 = qpos[qt] - (j0 * mc.KS + mc.KO);
#pragma unroll
            for (int kt = 0; kt < 4; ++kt) {
                float bv[4];
#pragma unroll
                for (int i = 0; i < 4; ++i) {
                    const int dist = d0 - (kt * 16 + i) * mc.KS;
                    const int dd = dist < 0 ? 0 : (dist > 128 ? 128 : dist);
                    bv[i] = BIAS ? L[gl * A_LUTS + dd] : 0.f;
                }
#pragma unroll
                for (int i = 0; i < 4; ++i) {
                    const int j = j0 + kt * 16 + i;
                    const int dist = d0 - (kt * 16 + i) * mc.KS;
                    const unsigned ok = (unsigned)(dist >= 0) & (unsigned)(dist < mc.W) & (unsigned)(j < mc.nk) & ((rmask[qt] >> (j >> mc.bsh)) & 1u);
                    const float s = __builtin_fmaf(S[kt][qt][i], mc.scale, bv[i] - mref[qt]);
                    S[kt][qt][i] = ok ? s : NEG_BIG;
                }
            }
        }
    }
}

template <int QT>
__device__ __forceinline__ void pv_tile(LAS unsigned char* lds, int vbuf, const s16x8 (&Pf)[2][QT], f32x4 (&O)[8][QT]) {
    const int lane = ltid() & 63, g4 = lane >> 4, q4 = (lane & 15) >> 2, p4 = lane & 3;
    const LAS unsigned char* vb = lds + A_VB0 + vbuf * A_VBSZ + (4 * g4 + q4) * VSTR + p4 * 8;
    __builtin_amdgcn_s_setprio(1);
    s16x4 va[3], vb2[3];
    va[0] = vtr(vb); vb2[0] = vtr(vb + 16 * VSTR);
    va[1] = vtr(vb + 32); vb2[1] = vtr(vb + 16 * VSTR + 32);
#pragma unroll
    for (int f = 0; f < 16; ++f) {
        const int kk = f >> 3, dt = f & 7;
        if (f + 2 < 16) { const int kk2 = (f + 2) >> 3, dt2 = (f + 2) & 7; va[(f + 2) % 3] = vtr(vb + (kk2 * 32) * VSTR + dt2 * 32); vb2[(f + 2) % 3] = vtr(vb + (kk2 * 32 + 16) * VSTR + dt2 * 32); }
        const s16x4 v0 = va[f % 3], v1 = vb2[f % 3];
        const s16x8 vf = (s16x8){v0[0], v0[1], v0[2], v0[3], v1[0], v1[1], v1[2], v1[3]};
#pragma unroll
        for (int qt = 0; qt < QT; ++qt) O[dt][qt] = __builtin_amdgcn_mfma_f32_16x16x32_bf16(vf, Pf[kk][qt], O[dt][qt], 0, 0, 0);
    }
    __builtin_amdgcn_sched_group_barrier(0x100, 4, 1);
#pragma unroll
    for (int f = 0; f < 16; ++f) {
        if (f + 2 < 16) __builtin_amdgcn_sched_group_barrier(0x100, 2, 1);
        __builtin_amdgcn_sched_group_barrier(0x008, QT, 1);
    }
    __builtin_amdgcn_s_setprio(0);
}

template <int DQK, int QT, bool BIAS, bool LAG = true>
__device__ __forceinline__ void attn_pass(LAS unsigned char* lds, const KVSrc<DQK>& src, unsigned long long act, const MaskCfg& mc,
                                          const s16x8 (&Qf)[QT][DQK / 32], f32x4 (&O)[8][QT], float (&m)[QT], float (&l)[QT],
                                          const int (&qpos)[QT], const unsigned (&rmask)[QT], int gl) {
    const int tidv = ltid(), lane = tidv & 63, g4 = lane >> 4;
    const bool lag = LAG && (__builtin_amdgcn_readfirstlane(tidv >> 8) != 0);
    if (act == 0ull) return;
    int qlo_w, qhi_w;
    { int a = qpos[0], b = qpos[0];
#pragma unroll
      for (int qt = 1; qt < QT; ++qt) { a = qpos[qt] < a ? qpos[qt] : a; b = qpos[qt] > b ? qpos[qt] : b; }
      qlo_w = wave_min_i(a); qhi_w = wave_max_i(b); }
    u32x4 kr[DQK / 64], vr[2];
    KVPlan<DQK> pl; kv_plan(src, pl);
    int jt = __builtin_ctzll(act); act &= act - 1ull;
    kv_gload(pl, jt, kr, vr);
    __syncthreads();
    kv_lstore(lds, 0, 0, pl, kr, vr);
    __syncthreads();
    int kbuf = 0, vbuf = 0;
    float lp[QT];
#pragma unroll
    for (int qt = 0; qt < QT; ++qt) lp[qt] = (g4 == 0) ? l[qt] : 0.f;
    s16x8 Pf[2][QT];
    bool havep = false;
    for (;;) {
        const bool has_next = (act != 0ull);
        int jn = 0;
        if (has_next) { jn = __builtin_ctzll(act); act &= act - 1ull; kv_gload(pl, jn, kr, vr); }
        if (lag && havep) { pv_tile<QT>(lds, vbuf == 0 ? 2 : vbuf - 1, Pf, O); havep = false; }
        const bool skip = ((jt * 64) * mc.KS + mc.KO > qhi_w) || (qlo_w - ((jt * 64 + 63) * mc.KS + mc.KO) >= mc.W);
        if (!skip) {
        f32x4 S[4][QT];
        float mref[QT];
#pragma unroll
        for (int qt = 0; qt < QT; ++qt) mref[qt] = (m[qt] < -1e29f) ? 0.f : m[qt];
        qk_tile<DQK, QT, BIAS>(lds, kbuf, jt, Qf, S, mc, qpos, rmask, gl, qlo_w, qhi_w, mref);
#pragma unroll
        for (int qt = 0; qt < QT; ++qt) {
            float mx = NEG_BIG;
#pragma unroll
            for (int kt = 0; kt < 4; ++kt)
#pragma unroll
                for (int i = 0; i < 4; ++i) mx = fmaxf(mx, S[kt][qt][i]);
            mx = rmax16(mx); mx = rmax32(mx);
            const float mold_rel = (m[qt] < -1e29f) ? NEG_BIG : 0.f;
            const float mnew_rel = fmaxf(mold_rel, mx);
            const float muse = (mnew_rel < -1e29f) ? 0.f : mnew_rel;
            const bool grow = (mold_rel < -1e29f) ? (mx > -1e29f) : (mx > 10.0f);
            if (__any(grow)) {
                const float alpha = __builtin_amdgcn_exp2f(mold_rel - mnew_rel);
#pragma unroll
                for (int kt = 0; kt < 4; ++kt)
#pragma unroll
                    for (int i = 0; i < 4; ++i) S[kt][qt][i] = __builtin_amdgcn_exp2f(S[kt][qt][i] - muse);
#pragma unroll
                for (int dt = 0; dt < 8; ++dt) O[dt][qt] *= alpha;
                lp[qt] *= alpha;
                m[qt] = mnew_rel + mref[qt];
            } else {
#pragma unroll
                for (int kt = 0; kt < 4; ++kt)
#pragma unroll
                    for (int i = 0; i < 4; ++i) S[kt][qt][i] = __builtin_amdgcn_exp2f(S[kt][qt][i]);
            }
            { f32x4 sv = (S[0][qt] + S[1][qt]) + (S[2][qt] + S[3][qt]); lp[qt] += (sv[0] + sv[1]) + (sv[2] + sv[3]); }
#pragma unroll
            for (int kk = 0; kk < 2; ++kk) {
                u32x4 w; w.x = pk2(S[2 * kk][qt][0], S[2 * kk][qt][1]); w.y = pk2(S[2 * kk][qt][2], S[2 * kk][qt][3]);
                w.z = pk2(S[2 * kk + 1][qt][0], S[2 * kk + 1][qt][1]); w.w = pk2(S[2 * kk + 1][qt][2], S[2 * kk + 1][qt][3]);
                Pf[kk][qt] = __builtin_bit_cast(s16x8, w);
            }
        }
        havep = true;
        if (!lag) pv_tile<QT>(lds, vbuf, Pf, O);
        }
        if (!has_next) break;
        const int vnext = vbuf == 2 ? 0 : vbuf + 1;
        kv_lstore(lds, kbuf ^ 1, vnext, pl, kr, vr);
        __syncthreads();
        kbuf ^= 1; vbuf = vnext; jt = jn;
    }
    if (lag && havep) pv_tile<QT>(lds, vbuf, Pf, O);
#pragma unroll
    for (int qt = 0; qt < QT; ++qt) l[qt] = rsum32(rsum16(lp[qt]));
}

template <int QT>
__device__ __forceinline__ void attn_init(f32x4 (&O)[8][QT], float (&m)[QT], float (&l)[QT]) {
#pragma unroll
    for (int qt = 0; qt < QT; ++qt) { m[qt] = NEG_BIG; l[qt] = 0.f;
#pragma unroll
        for (int dt = 0; dt < 8; ++dt) O[dt][qt] = (f32x4){0.f, 0.f, 0.f, 0.f}; }
}
template <int QT>
__device__ __forceinline__ void attn_store(const f32x4 (&O)[8][QT], const float (&l)[QT], bf16_t* const (&orow)[QT]) {
    const int g4 = (ltid() & 63) >> 4;
#pragma unroll
    for (int qt = 0; qt < QT; ++qt) { const float inv = 1.0f / fmaxf(l[qt], 1e-30f);
#pragma unroll
        for (int dt = 0; dt < 8; ++dt) { const f32x4 o = O[dt][qt] * inv; u32x2 w; w.x = pk2(o[0], o[1]); w.y = pk2(o[2], o[3]); *(u32x2*)(orow[qt] + dt * 16 + 4 * g4) = w; } }
}
__device__ __forceinline__ int qc_order(int t, int per, int nq) { const int r = t / per; const int q = r % nq; return (r / nq) * 0 + ((r & 1) ? q : (nq - 1 - q)); }

__device__ __forceinline__ void moba_kmean_phase(const Params& p, LAS unsigned char* lds) {
    const int tid = ltid(); LAS float* R = (LAS float*)lds;
    for (int job = blockIdx.x; job < NB * NHEAD * 8; job += gridDim.x) {
        const int blk = job & 7, h = (job >> 3) & 15, b = job >> 7;
        const int d8 = (tid & 15) * 8, jg = tid >> 4;
        float acc[8];
#pragma unroll
        for (int e = 0; e < 8; ++e) acc[e] = 0.f;
#pragma unroll
        for (int i = 0; i < 8; ++i) {
            const int j = jg + 32 * i;
            const s16x8 v = *(const s16x8*)(p.proj + (size_t)(b * SEQ + blk * 256 + j) * MOBA_LD + 2048 + h * HD + d8);
#pragma unroll
            for (int e = 0; e < 8; ++e) acc[e] += bf2f((bf16_t)v[e]);
        }
        __syncthreads();
#pragma unroll
        for (int e = 0; e < 8; ++e) R[jg * 128 + d8 + e] = acc[e];
        __syncthreads();
        if (tid < 128) { float s = 0.f; for (int g = 0; g < 32; ++g) s += R[g * 128 + tid]; p.kmean[(size_t)job * 128 + tid] = s * (1.0f / 256.0f); }
    }
    __syncthreads();
}

__device__ __forceinline__ void moba_attn_phase(const Params& p, LAS unsigned char* lds) {
    const int tid = ltid(), lane = tid & 63, wave = tid >> 6, fr = lane & 15, g4 = lane >> 4;
    LAS unsigned* RM = (LAS unsigned*)(lds + A_RMASK); LAS unsigned* UM = (LAS unsigned*)(lds + A_UMASK);
    for (int t = blockIdx.x; t < NB * NHEAD * 8; t += gridDim.x) {
        const int per = NB * NHEAD, n = (t / per) < 4 ? (7 - t / per) : (t / per - 4), bh = t % per, b = bh >> 4, h = bh & 15;
        __syncthreads();
        build_lut(lds, p.rel_bias, h, 1);
        if (tid == 0) UM[0] = 0u;
        __syncthreads();
        if (tid < 256) {
            unsigned mask = 1u << n;
            if (n <= 3) mask |= (1u << n) - 1u;
            else {
                const bf16_t* qr = p.proj + (size_t)(b * SEQ + n * 256 + tid) * MOBA_LD + h * HD;
                float g0 = 0.f, g1 = 0.f, g2 = 0.f, g3 = 0.f, g5 = 0.f, g6 = 0.f, g7 = 0.f;
                float gate[7];
#pragma unroll
                for (int j = 0; j < 7; ++j) gate[j] = 0.f;
                const float* km = p.kmean + (size_t)(b * NHEAD + h) * 8 * 128;
                for (int d8 = 0; d8 < 128; d8 += 8) {
                    const s16x8 qv = *(const s16x8*)(qr + d8);
#pragma unroll
                    for (int j = 0; j < 7; ++j) if (j < n) {
                        const f32x4 k0 = *(const f32x4*)(km + j * 128 + d8), k1 = *(const f32x4*)(km + j * 128 + d8 + 4);
#pragma unroll
                        for (int e = 0; e < 4; ++e) gate[j] += bf2f((bf16_t)qv[e]) * k0[e] + bf2f((bf16_t)qv[4 + e]) * k1[e];
                    }
                }
                (void)g0; (void)g1; (void)g2; (void)g3; (void)g5; (void)g6; (void)g7;
                unsigned picked = 0u;
#pragma unroll
                for (int r = 0; r < 3; ++r) {
                    float best = -3e38f; int bi = 0;
#pragma unroll
                    for (int j = 0; j < 7; ++j) if (j < n && !((picked >> j) & 1u) && gate[j] > best) { best = gate[j]; bi = j; }
                    picked |= 1u << bi;
                }
                mask |= picked;
            }
            RM[tid] = mask; atomicOr((unsigned*)UM, mask);
        }
        __syncthreads();
        const unsigned um = UM[0];
        unsigned long long act = 0ull;
        for (int j = 0; j <= n; ++j) if ((um >> j) & 1u) act |= 0xFull << (4 * j);
        int qpos[2]; unsigned rmask[2]; int gl = 0; s16x8 Qf[2][4]; bf16_t* orow[2];
#pragma unroll
        for (int qt = 0; qt < 2; ++qt) {
            const int r = ((wave < 4) ? wave : 11 - wave) * 32 + qt * 16 + fr; qpos[qt] = n * 256 + r; rmask[qt] = RM[r];
            const bf16_t* qr = p.proj + (size_t)(b * SEQ + qpos[qt]) * MOBA_LD + h * HD + g4 * 8;
#pragma unroll
            for (int ks = 0; ks < 4; ++ks) Qf[qt][ks] = *(const s16x8*)(qr + ks * 32);
            orow[qt] = p.att + (size_t)(b * SEQ + qpos[qt]) * DM + h * HD;
        }
        KVSrc<128> src{p.proj + (size_t)b * SEQ * MOBA_LD + 2048 + h * HD, (size_t)MOBA_LD, nullptr, 0, p.proj + (size_t)b * SEQ * MOBA_LD + 4096 + h * HD, (size_t)MOBA_LD, SEQ};
        MaskCfg mc{1, 0, 1 << 30, 8, SEQ, 0.08838834764831845f * 1.4426950408889634f};
        f32x4 O[8][2]; float m[2], l[2];
        attn_init<2>(O, m, l);
        attn_pass<128, 2, true>(lds, src, act, mc, Qf, O, m, l, qpos, rmask, gl);
        attn_store<2>(O, l, orow);
    }
    __syncthreads();
}

__device__ __forceinline__ void swa_attn_phase(const Params& p, LAS unsigned char* lds) {
    const int tid = ltid(), lane = tid & 63, wave = tid >> 6, fr = lane & 15, g4 = lane >> 4;
    for (int t = blockIdx.x; t < NB * 2 * 64; t += gridDim.x) {
        const int qc = t >> 3, bk = t & 7, b = bk >> 1, hk = bk & 1, q0 = qc * 32;
        __syncthreads();
        build_lut(lds, p.rel_bias, hk * 8, 8);
        __syncthreads();
        int qpos[2]; unsigned rmask[2]; int gl = 0; s16x8 Qf[2][4]; bf16_t* orow[2];
        const int head = hk * 8 + wave;
#pragma unroll
        for (int qt = 0; qt < 2; ++qt) {
            qpos[qt] = q0 + qt * 16 + fr; rmask[qt] = 0xFFFFFFFFu; gl = __builtin_amdgcn_readfirstlane(wave);
            const bf16_t* qr = p.proj + (size_t)(b * SEQ + qpos[qt]) * SWA_LD + head * HD + g4 * 8;
#pragma unroll
            for (int ks = 0; ks < 4; ++ks) Qf[qt][ks] = *(const s16x8*)(qr + ks * 32);
            orow[qt] = p.att + (size_t)(b * SEQ + qpos[qt]) * DM + head * HD;
        }
        KVSrc<128> src{p.proj + (size_t)b * SEQ * SWA_LD + 2048 + hk * HD, (size_t)SWA_LD, nullptr, 0, p.proj + (size_t)b * SEQ * SWA_LD + 2304 + hk * HD, (size_t)SWA_LD, SEQ};
        MaskCfg mc{1, 0, 128, 31, SEQ, 0.08838834764831845f * 1.4426950408889634f};
        const int tlo = (q0 - 127 < 0 ? 0 : q0 - 127) >> 6, thi = (q0 + 31) >> 6;
        unsigned long long act = 0ull;
        for (int j = tlo; j <= thi; ++j) act |= 1ull << j;
        f32x4 O[8][2]; float m[2], l[2];
        attn_init<2>(O, m, l);
        const float sink = p.swa_sinks[head] * 1.4426950408889634f;
        m[0] = sink; m[1] = sink; l[0] = 1.f; l[1] = 1.f;
        attn_pass<128, 2, true>(lds, src, act, mc, Qf, O, m, l, qpos, rmask, gl);
        attn_store<2>(O, l, orow);
    }
    __syncthreads();
}

__device__ __forceinline__ void mla_norm_phase(const Params& p) {
    const int tid = ltid(), lane = tid & 63, wave = tid >> 6;
    for (int row = blockIdx.x * 8 + wave; row < NTOK; row += gridDim.x * 8) {
        const float* cr = p.cdown + (size_t)row * MLA_DN_LD;
#pragma unroll
        for (int part = 0; part < 2; ++part) {
            f32x4 v[2]; float s = 0.f;
#pragma unroll
            for (int i = 0; i < 2; ++i) { v[i] = *(const f32x4*)(cr + part * 512 + i * 256 + lane * 4); s += (v[i][0] * v[i][0] + v[i][1] * v[i][1]) + (v[i][2] * v[i][2] + v[i][3] * v[i][3]); }
#pragma unroll
            for (int o = 32; o > 0; o >>= 1) s += __shfl_xor(s, o);
            const float r = rsqrtf(s * (1.0f / 512.0f) + 1e-6f);
            const float* gw = part ? p.kv_norm : p.q_norm; bf16_t* dst = (part ? p.ckvn : p.cqn) + (size_t)row * 512;
#pragma unroll
            for (int i = 0; i < 2; ++i) { const int c = i * 256 + lane * 4; const f32x4 gg = *(const f32x4*)(gw + c); const f32x4 o = v[i] * r * gg;
                u32x2 w; w.x = pk2(o[0], o[1]); w.y = pk2(o[2], o[3]); *(u32x2*)(dst + c) = w; }
        }
        if (lane < 32) {
            const int s = row % SEQ; const float t1 = cr[1024 + lane], t2 = cr[1024 + 32 + lane];
            const float c = p.rope[s * 64 + lane], sn = p.rope[s * 64 + 32 + lane];
            p.krope[(size_t)row * 64 + lane] = f2bf(t1 * c - t2 * sn); p.krope[(size_t)row * 64 + 32 + lane] = f2bf(t1 * sn + t2 * c);
        }
    }
}

__device__ __forceinline__ void mla_attn_phase(const Params& p, LAS unsigned char* lds) {
    const int tid = ltid(), lane = tid & 63, wave = tid >> 6, fr = lane & 15, g4 = lane >> 4;
    for (int t = blockIdx.x; t < NB * NHEAD * 8; t += gridDim.x) {
        const int per = NB * NHEAD, n = (t / per) < 4 ? (7 - t / per) : (t / per - 4), bh = t % per, b = bh >> 4, h = bh & 15;
        int qpos[2]; unsigned rmask[2]; int gl = 0; s16x8 Qf[2][6]; bf16_t* orow[2];
#pragma unroll
        for (int qt = 0; qt < 2; ++qt) {
            const int r = ((wave < 4) ? wave : 11 - wave) * 32 + qt * 16 + fr; qpos[qt] = n * 256 + r; rmask[qt] = 0xFFFFFFFFu;
            const bf16_t* qr = p.proj + (size_t)(b * SEQ + qpos[qt]) * MLA_Q_LD + h * 192 + g4 * 8;
#pragma unroll
            for (int ks = 0; ks < 6; ++ks) Qf[qt][ks] = *(const s16x8*)(qr + ks * 32);
            const float* rp = p.rope + qpos[qt] * 64 + g4 * 8;
            s16x8 a = Qf[qt][4], c2 = Qf[qt][5];
#pragma unroll
            for (int e = 0; e < 8; ++e) { const float t1 = bf2f((bf16_t)a[e]), t2 = bf2f((bf16_t)c2[e]), cs = rp[e], sn = rp[32 + e];
                a[e] = (short)f2bf(t1 * cs - t2 * sn); c2[e] = (short)f2bf(t1 * sn + t2 * cs); }
            Qf[qt][4] = a; Qf[qt][5] = c2;
            orow[qt] = p.att + (size_t)(b * SEQ + qpos[qt]) * DM + h * HD;
        }
        const bf16_t* kvb = p.proj + (size_t)NTOK * MLA_Q_LD + (size_t)b * SEQ * MLA_KV_LD + h * 256;
        KVSrc<192> src{kvb, (size_t)MLA_KV_LD, p.krope + (size_t)b * SEQ * 64, 64, kvb + 128, (size_t)MLA_KV_LD, SEQ};
        MaskCfg mc{1, 0, 1 << 30, 31, SEQ, 0.07216878364870322f * 1.4426950408889634f};
        unsigned long long act = 0ull;
        for (int j = 0; j < 4 * (n + 1); ++j) act |= 1ull << j;
        f32x4 O[8][2]; float m[2], l[2];
        attn_init<2>(O, m, l);
        attn_pass<192, 2, false, false>(lds, src, act, mc, Qf, O, m, l, qpos, rmask, gl);
        attn_store<2>(O, l, orow);
    }
    __syncthreads();
}

__device__ __forceinline__ float gelu_tanh(float x) { const float u = 0.7978845608028654f * (x + 0.044715f * x * x * x); const float e = __expf(2.0f * u); const float th = 1.0f - 2.0f * __builtin_amdgcn_rcpf(e + 1.0f); return 0.5f * x * (1.0f + th); }

__device__ __forceinline__ void nsa_cmp1_phase(const Params& p, LAS unsigned char* lds) {
    const int tid = ltid(), lane = tid & 63, wave = tid >> 6, fr = lane & 15, g4 = lane >> 4;
    for (int t = blockIdx.x; t < 256; t += gridDim.x) {
        const int nq = t & 7, bk = (t >> 3) & 15, kv = t >> 7, b = bk >> 2, hk = bk & 3;
        const int c = wave * 16 + fr;
        const bf16_t* arow = (c < 127) ? p.proj + (size_t)(b * SEQ + c * 16) * NSA_LD + 2048 + kv * 512 + hk * HD + g4 * 8 : p.pe_b16 + kv * 4096 + g4 * 8;
        const size_t lstr = (c < 127) ? (size_t)NSA_LD : (size_t)128;
        const bf16_t* brow = p.w_cmp1 + (size_t)kv * 256 * 4096 + (size_t)(nq * 32 + fr) * 4096 + g4 * 8;
        f32x4 acc[2];
#pragma unroll
        for (int i = 0; i < 2; ++i) acc[i] = (f32x4){0.f, 0.f, 0.f, 0.f};
#pragma unroll 1
        for (int l8 = 0; l8 < 32; l8 += 2) {
            s16x8 af[8], bf[8][2];
#pragma unroll
            for (int u = 0; u < 8; ++u) { const int ks = l8 * 4 + u;
                af[u] = *(const s16x8*)(arow + (size_t)(ks >> 2) * lstr + (ks & 3) * 32);
                bf[u][0] = *(const s16x8*)(brow + ks * 32); bf[u][1] = *(const s16x8*)(brow + (size_t)16 * 4096 + ks * 32); }
#pragma unroll
            for (int u = 0; u < 8; ++u) { acc[0] = __builtin_amdgcn_mfma_f32_16x16x32_bf16(bf[u][0], af[u], acc[0], 0, 0, 0); acc[1] = __builtin_amdgcn_mfma_f32_16x16x32_bf16(bf[u][1], af[u], acc[1], 0, 0, 0); }
        }
        LAS float* PB = (LAS float*)lds;
        __syncthreads();
        if (c == 127) {
#pragma unroll
            for (int nt = 0; nt < 2; ++nt) *(LAS f32x4*)(PB + nt * 16 + 4 * g4) = acc[nt];
        }
        __syncthreads();
        bf16_t* orow = p.cmp_hid + ((size_t)(kv * 16 + bk) * 128 + c) * 256 + nq * 32;
#pragma unroll
        for (int nt = 0; nt < 2; ++nt) { const int n0 = nt * 16 + 4 * g4; const f32x4 pb = *(const LAS f32x4*)(PB + n0);
            const f32x4 v = acc[nt] + pb; u32x2 w; w.x = pk2(gelu_tanh(v[0]), gelu_tanh(v[1])); w.y = pk2(gelu_tanh(v[2]), gelu_tanh(v[3])); *(u32x2*)(orow + n0) = w; }
    }
}
__device__ __forceinline__ void nsa_cmp2_phase(const Params& p) {
    const int tid = ltid(), lane = tid & 63, wave = tid >> 6, fr = lane & 15, g4 = lane >> 4;
    for (int t = blockIdx.x; t < 32; t += gridDim.x) {
        const int bk = t & 15, kv = t >> 4; const int c = wave * 16 + fr;
        const bf16_t* arow = p.cmp_hid + ((size_t)(kv * 16 + bk) * 128 + c) * 256 + g4 * 8;
        const bf16_t* brow = p.w_cmp2 + (size_t)kv * 128 * 256 + (size_t)fr * 256 + g4 * 8;
        f32x4 acc[8];
#pragma unroll
        for (int i = 0; i < 8; ++i) acc[i] = (f32x4){0.f, 0.f, 0.f, 0.f};
#pragma unroll
        for (int ks = 0; ks < 8; ++ks) {
            const s16x8 af = *(const s16x8*)(arow + ks * 32);
#pragma unroll
            for (int nt = 0; nt < 8; ++nt) { const s16x8 bf = *(const s16x8*)(brow + (size_t)nt * 16 * 256 + ks * 32);
                acc[nt] = __builtin_amdgcn_mfma_f32_16x16x32_bf16(bf, af, acc[nt], 0, 0, 0); }
        }
        bf16_t* orow = p.kcvc + ((size_t)(kv * 16 + bk) * 128 + c) * 128;
#pragma unroll
        for (int nt = 0; nt < 8; ++nt) { f32x4 v = acc[nt]; if (c >= 127) v = (f32x4){0.f, 0.f, 0.f, 0.f};
            u32x2 w; w.x = pk2(v[0], v[1]); w.y = pk2(v[2], v[3]); *(u32x2*)(orow + nt * 16 + 4 * g4) = w; }
    }
}

template <bool FIRST>
__device__ __forceinline__ void nsa_add_branch(bf16_t* const (&orow)[2], const f32x4 (&O)[8][2], const float (&l)[2], const float (&gate)[2]) {
    const int g4 = (ltid() & 63) >> 4;
#pragma unroll
    for (int qt = 0; qt < 2; ++qt) { const float sc = gate[qt] / fmaxf(l[qt], 1e-30f);
#pragma unroll
        for (int dt = 0; dt < 8; ++dt) {
            u32x2* dp = (u32x2*)(orow[qt] + dt * 16 + 4 * g4);
            f32x4 o = O[dt][qt] * sc;
            if (!FIRST) { const u32x2 w = *dp;
                o[0] += __uint_as_float(w.x << 16); o[1] += __uint_as_float(w.x & 0xffff0000u); o[2] += __uint_as_float(w.y << 16); o[3] += __uint_as_float(w.y & 0xffff0000u); }
            u32x2 r; r.x = pk2(o[0], o[1]); r.y = pk2(o[2], o[3]); *dp = r; } }
}

__device__ __forceinline__ void nsa_attn_phase(const Params& p, LAS unsigned char* lds) {
    const int tid = ltid(), lane = tid & 63, wave = tid >> 6, fr = lane & 15, g4 = lane >> 4;
    LAS unsigned* RM = (LAS unsigned*)(lds + A_RMASK); LAS unsigned* UM = (LAS unsigned*)(lds + A_UMASK);
    LAS float* IMPG = (LAS float*)(lds + A_VB0);
    LAS float* IMPF = (LAS float*)(lds + A_IMP);
    for (int t = blockIdx.x; t < NB * 4 * 32; t += gridDim.x) {
        const int r_ = (t >> 4) & 31, qc = (r_ < 16) ? (31 - r_) : (r_ - 16), bk = t & 15, b = bk >> 2, hk = bk & 3, q0 = qc * 64;
        __syncthreads();
        build_lut(lds, p.rel_bias, hk * 4, 4);
        if (tid == 0) UM[0] = 0u;
        __syncthreads();
        const int g = wave >> 1, head = hk * 4 + g;
        int qpos[2]; unsigned rmask[2]; const int gl = __builtin_amdgcn_readfirstlane(g); s16x8 Qf[2][4];
#pragma unroll
        for (int qt = 0; qt < 2; ++qt) {
            qpos[qt] = q0 + (((wave & 1) ^ (wave >> 2)) & 1) * 32 + qt * 16 + fr; rmask[qt] = 0xFFFFFFFFu;
            const size_t tok = (size_t)(b * SEQ + qpos[qt]);
            const bf16_t* qr = p.proj + tok * NSA_LD + head * HD + g4 * 8;
#pragma unroll
            for (int ks = 0; ks < 4; ++ks) Qf[qt][ks] = *(const s16x8*)(qr + ks * 32);
        }
        f32x4 O[8][2]; float m[2], l[2];
        const float scale = 0.08838834764831845f * 1.4426950408889634f;
        {
            const bf16_t* kc = p.kcvc + (size_t)(0 * 16 + bk) * 128 * 128; const bf16_t* vc = p.kcvc + (size_t)(1 * 16 + bk) * 128 * 128;
            KVSrc<128> src{kc, 128, nullptr, 0, vc, 128, 127};
            MaskCfg mc{16, 31, 1 << 30, 31, 127, scale};
            const bool two = ((q0 + 32) >> 4) >= 64;
            unsigned long long act = two ? 3ull : 1ull;
            attn_init<2>(O, m, l);
            attn_pass<128, 2, true>(lds, src, act, mc, Qf, O, m, l, qpos, rmask, gl);
            { float gt[2];
#pragma unroll
              for (int qt = 0; qt < 2; ++qt) gt[qt] = 1.0f / (1.0f + __expf(-bf2f(p.proj[(size_t)(b * SEQ + qpos[qt]) * NSA_LD + 5120 + head * 3 + 0])));
              bf16_t* orow[2] = {p.att + (size_t)(b * SEQ + qpos[0]) * DM + head * HD, p.att + (size_t)(b * SEQ + qpos[1]) * DM + head * HD};
              nsa_add_branch<true>(orow, O, l, gt); }
            __syncthreads();
            const int qlo = wave_min_i(qpos[0] < qpos[1] ? qpos[0] : qpos[1]), qhi = wave_max_i(qpos[0] > qpos[1] ? qpos[0] : qpos[1]);
            float carry[2] = {0.f, 0.f};
            float mrf[2] = {(m[0] < -1e29f) ? 0.f : m[0], (m[1] < -1e29f) ? 0.f : m[1]};
#pragma unroll
            for (int jt = 0; jt < 2; ++jt) {
                if (jt == 0 || two) {
                    f32x4 S[4][2];
                    qk_tile<128, 2, true>(lds, jt, jt, Qf, S, mc, qpos, rmask, gl, qlo, qhi, mrf);
#pragma unroll
                    for (int qt = 0; qt < 2; ++qt) {
                        const float inv = 1.0f / fmaxf(l[qt], 1e-30f);
                        float p3[4], s4[4];
#pragma unroll
                        for (int kt = 0; kt < 4; ++kt) {
                            float pv[4];
#pragma unroll
                            for (int i = 0; i < 4; ++i) pv[i] = __builtin_amdgcn_exp2f(S[kt][qt][i]) * inv;
                            s4[kt] = (pv[0] + pv[1]) + (pv[2] + pv[3]); p3[kt] = pv[3];
                        }
#pragma unroll
                        for (int kt = 0; kt < 4; ++kt) {
                            const float fromlane = __shfl(p3[kt], (lane + 48) & 63);
                            const float wrap = __shfl(kt > 0 ? p3[kt > 0 ? kt - 1 : 0] : carry[qt], (lane + 48) & 63);
                            const float prev = (g4 > 0) ? fromlane : wrap;
                            IMPG[(g * 64 + (qpos[qt] - q0)) * 32 + jt * 16 + kt * 4 + g4] = s4[kt] + prev;
                        }
                        carry[qt] = p3[3];
                    }
                } else {
#pragma unroll
                    for (int qt = 0; qt < 2; ++qt)
#pragma unroll
                        for (int kt = 0; kt < 4; ++kt) IMPG[(g * 64 + (qpos[qt] - q0)) * 32 + 16 + kt * 4 + g4] = 0.f;
                }
            }
        }
        __syncthreads();
        for (int i = tid; i < 64 * 32; i += 512) IMPF[i] = (IMPG[i] + IMPG[2048 + i]) + (IMPG[4096 + i] + IMPG[6144 + i]);
        __syncthreads();
#pragma unroll 1
        for (int rep = 0; rep < 4; ++rep) {
            const int pair = tid + rep * 512, q = pair >> 5, j = pair & 31;
            const int qb = (q0 + q) >> 6;
            unsigned F = 1u | (1u << qb); if (qb >= 1) F |= 1u << (qb - 1);
            const int need = 16 - __builtin_popcount(F);
            const unsigned V = (qb >= 31) ? 0xFFFFFFFFu : ((2u << qb) - 1u), C = V & ~F;
            bool sel = (F >> j) & 1u;
            if ((C >> j) & 1u) {
                const float vj = IMPF[q * 32 + j]; int rank = 0;
#pragma unroll
                for (int i = 0; i < 32; ++i) { const float vi = IMPF[q * 32 + i]; rank += (((C >> i) & 1u) && (vi > vj || (vi == vj && i < j))) ? 1 : 0; }
                sel = rank < need;
            }
            const unsigned long long bal = __ballot(sel);
            if (lane == 0) { RM[q] = (unsigned)bal; atomicOr((unsigned*)UM, (unsigned)bal); }
            if (lane == 32) { RM[q] = (unsigned)(bal >> 32); atomicOr((unsigned*)UM, (unsigned)(bal >> 32)); }
        }
        __syncthreads();
        {
            rmask[0] = RM[qpos[0] - q0]; rmask[1] = RM[qpos[1] - q0];
            const unsigned um = UM[0];
            unsigned long long act = 0ull;
            for (int j = 0; j <= qc; ++j) if ((um >> j) & 1u) act |= 1ull << j;
            KVSrc<128> src{p.proj + (size_t)b * SEQ * NSA_LD + 3072 + hk * HD, (size_t)NSA_LD, nullptr, 0, p.proj + (size_t)b * SEQ * NSA_LD + 3584 + hk * HD, (size_t)NSA_LD, SEQ};
            MaskCfg mc{1, 0, 1 << 30, 6, SEQ, scale};
            attn_init<2>(O, m, l);
            attn_pass<128, 2, true>(lds, src, act, mc, Qf, O, m, l, qpos, rmask, gl);
            { float gt[2];
#pragma unroll
              for (int qt = 0; qt < 2; ++qt) gt[qt] = 1.0f / (1.0f + __expf(-bf2f(p.proj[(size_t)(b * SEQ + qpos[qt]) * NSA_LD + 5120 + head * 3 + 1])));
              bf16_t* orow[2] = {p.att + (size_t)(b * SEQ + qpos[0]) * DM + head * HD, p.att + (size_t)(b * SEQ + qpos[1]) * DM + head * HD};
              nsa_add_branch<false>(orow, O, l, gt); }
        }
        {
            rmask[0] = 0xFFFFFFFFu; rmask[1] = 0xFFFFFFFFu;
            const int tlo = (q0 - 511 < 0 ? 0 : q0 - 511) >> 6;
            unsigned long long act = 0ull;
            for (int j = tlo; j <= qc; ++j) act |= 1ull << j;
            KVSrc<128> src{p.proj + (size_t)b * SEQ * NSA_LD + 4096 + hk * HD, (size_t)NSA_LD, nullptr, 0, p.proj + (size_t)b * SEQ * NSA_LD + 4608 + hk * HD, (size_t)NSA_LD, SEQ};
            MaskCfg mc{1, 0, 512, 31, SEQ, scale};
            attn_init<2>(O, m, l);
            attn_pass<128, 2, true>(lds, src, act, mc, Qf, O, m, l, qpos, rmask, gl);
            { float gt[2];
#pragma unroll
              for (int qt = 0; qt < 2; ++qt) gt[qt] = 1.0f / (1.0f + __expf(-bf2f(p.proj[(size_t)(b * SEQ + qpos[qt]) * NSA_LD + 5120 + head * 3 + 2])));
              bf16_t* orow[2] = {p.att + (size_t)(b * SEQ + qpos[0]) * DM + head * HD, p.att + (size_t)(b * SEQ + qpos[1]) * DM + head * HD};
              nsa_add_branch<false>(orow, O, l, gt); }
        }
    }
    __syncthreads();
}

#define XB_TMO      128
#define XB_XCNT(j)  (256  + 64 * (j))
#define XB_XSUB(j)  (1280 + 64 * (j))
#define XB_XGEN(j)  (2304 + 64 * (j))
#define XB_TOP      3328
#define XB_TOPGEN   3392
#define XCD_BAR_WORDS 3456
#define XB_SPIN_CAP (1u << 18)

__device__ __forceinline__ unsigned xb_ld(unsigned* p)              { return __hip_atomic_load(p, __ATOMIC_RELAXED, __HIP_MEMORY_SCOPE_AGENT); }
__device__ __forceinline__ unsigned xb_add(unsigned* p, unsigned v) { return __hip_atomic_fetch_add(p, v, __ATOMIC_RELAXED, __HIP_MEMORY_SCOPE_AGENT); }
__device__ __forceinline__ unsigned xb_xcc_id() { return (unsigned)__builtin_amdgcn_s_getreg((3 << 11) | 20) & 0xFu; }
#define XB_SPIN(cond, bar) do { unsigned _sp = 0; while (cond) { __builtin_amdgcn_s_sleep(1); \
    if ((++_sp & 255u) == 0u) { if (xb_ld(&(bar)[XB_TMO])) break; if (_sp > XB_SPIN_CAP) { atomicAdd(&(bar)[XB_TMO], 1u); break; } } } } while (0)

struct XcdBarrier {
    unsigned* bar; unsigned x;
    volatile LAS unsigned* st;
};

__device__ __forceinline__ XcdBarrier xcd_barrier_post(unsigned* bar, volatile LAS unsigned* st) {
    XcdBarrier b; b.bar = bar; b.x = xb_xcc_id(); b.st = st;
    if (threadIdx.x == 0) (void)xb_add(&bar[XB_XCNT(b.x)], 1u);
    return b;
}
__device__ __forceinline__ void xcd_barrier_complete(unsigned* bar, unsigned x, unsigned& nloc, unsigned& nx) {
    const unsigned G = gridDim.x * gridDim.y * gridDim.z;
    unsigned sum, cnt, mine, sp = 0u;
    for (;;) {
        sum = 0u; cnt = 0u; mine = 0u;
#pragma unroll
        for (unsigned j = 0; j < 16; ++j) { const unsigned c = xb_ld(&bar[XB_XCNT(j)]); sum += c; cnt += (c > 0u) ? 1u : 0u; mine = (j == x) ? c : mine; }
        if (sum == G) break;
        __builtin_amdgcn_s_sleep(1);
        if ((++sp & 255u) == 0u) { if (xb_ld(&bar[XB_TMO])) break; if (sp > XB_SPIN_CAP) { atomicAdd(&bar[XB_TMO], 1u); break; } }
    }
    nloc = mine > 0u ? mine : 1u; nx = cnt > 0u ? cnt : 1u;
}

__device__ __forceinline__ void xcd_barrier(const XcdBarrier& b) {
    asm volatile("s_waitcnt vmcnt(0)" ::: "memory");
    __syncthreads();
    if (threadIdx.x == 0) {
        unsigned* bar = b.bar;
        __builtin_amdgcn_s_waitcnt(0);
        unsigned nloc = b.st[0], nx = b.st[1];
        if (nloc == 0u) { xcd_barrier_complete(bar, b.x, nloc, nx); b.st[0] = nloc; b.st[1] = nx; }
        const unsigned old = xb_add(&bar[XB_XSUB(b.x)], 1u);
        const unsigned gen = old / nloc;
        if (old + 1u == (gen + 1u) * nloc) {
            __builtin_amdgcn_fence(__ATOMIC_RELEASE, "agent");
            asm volatile("s_waitcnt vmcnt(0)" ::: "memory");
            const unsigned og = xb_add(&bar[XB_TOP], 1u);
            const unsigned tg = og / nx;
            if (og + 1u == (tg + 1u) * nx) xb_add(&bar[XB_TOPGEN], 1u);
            else XB_SPIN(xb_ld(&bar[XB_TOPGEN]) == tg, bar);
            __builtin_amdgcn_fence(__ATOMIC_ACQUIRE, "agent");
            xb_add(&bar[XB_XGEN(b.x)], 1u);
            asm volatile("s_waitcnt vmcnt(0)" ::: "memory");
        } else {
            XB_SPIN(xb_ld(&bar[XB_XGEN(b.x)]) == gen, bar);
            __builtin_amdgcn_fence(__ATOMIC_ACQUIRE, "agent");
            asm volatile("s_waitcnt vmcnt(0)" ::: "memory");
        }
    }
    __syncthreads();
}


typedef _Float16 h16x4 __attribute__((ext_vector_type(4)));
struct EpiResLN {
    static constexpr bool PERM = false, AFTER_DRAIN = true;
    const float* base32; const _Float16* base16; float alpha; const float* g; const float* b; float* out32; _Float16* xh; bf16_t* xb; unsigned long long* stats; unsigned* cnt; unsigned need; unsigned* tmo;
    __device__ __forceinline__ void fused(pg8::f32x4 (&acc)[2][2][4][2], const pg8::Unit& u, int wr, int wc, int fr, int fq, LAS unsigned char* lds, int wid, int lane) const {
        typedef float f32x2v __attribute__((ext_vector_type(2)));
        LAS f32x2v* P = (LAS f32x2v*)lds;
        LAS f32x2v* ST = (LAS f32x2v*)(lds + 8192);
        const int row0 = u.pm * 256 + wr * 64 + fr, col0 = u.pn * 256 + wc * 32 + 4 * fq;
#pragma unroll
        for (int ai = 0; ai < 2; ++ai)
#pragma unroll
            for (int m = 0; m < 4; ++m) {
                const size_t off = (size_t)(row0 + ai * 128 + m * 16) * DM + col0;
                float s = 0.f, q = 0.f;
#pragma unroll
                for (int bj = 0; bj < 2; ++bj)
#pragma unroll
                    for (int n = 0; n < 2; ++n) { f32x4 bs;
                        if (base32) bs = *(const f32x4*)(base32 + off + bj * 128 + n * 16);
                        else bs = __builtin_convertvector(*(const h16x4*)(base16 + off + bj * 128 + n * 16), f32x4);
                        const f32x4 v = bs * alpha + acc[ai][bj][m][n]; acc[ai][bj][m][n] = v;
                        s += (v[0] + v[1]) + (v[2] + v[3]); q += (v[0] * v[0] + v[1] * v[1]) + (v[2] * v[2] + v[3] * v[3]); }
                s = rsum32(rsum16(s)); q = rsum32(rsum16(q));
                if (fq == 0) P[(ai * 128 + wr * 64 + m * 16 + fr) * 4 + wc] = (f32x2v){s, q};
                asm volatile("" ::: "memory");
            }
        __syncthreads();
        const int tid = wid * 64 + lane;
        if (tid < 256) {
            const f32x2v a = P[tid * 4 + 0], b2 = P[tid * 4 + 1], c = P[tid * 4 + 2], d = P[tid * 4 + 3];
            const float S = (a.x + b2.x) + (c.x + d.x), Q = (a.y + b2.y) + (c.y + d.y);
            __hip_atomic_store(stats + ((size_t)(u.pm * 256 + tid) * 8 + u.pn), ((unsigned long long)__float_as_uint(Q) << 32) | __float_as_uint(S), __ATOMIC_RELAXED, __HIP_MEMORY_SCOPE_AGENT);
        }
        asm volatile("s_waitcnt vmcnt(0)" ::: "memory");
        __syncthreads();
        if (tid == 0) {
            __hip_atomic_fetch_add(cnt + 64 * u.pm, 1u, __ATOMIC_RELAXED, __HIP_MEMORY_SCOPE_AGENT);
            unsigned sp = 0;
            while (__hip_atomic_load(cnt + 64 * u.pm, __ATOMIC_RELAXED, __HIP_MEMORY_SCOPE_AGENT) < need) {
                __builtin_amdgcn_s_sleep(1);
                if (++sp > (1u << 22)) { __hip_atomic_store(tmo, 1u, __ATOMIC_RELAXED, __HIP_MEMORY_SCOPE_AGENT); break; }
            }
        }
        __syncthreads();
        if (tid < 256) {
            const unsigned long long* sp = stats + (size_t)(u.pm * 256 + tid) * 8;
            float S = 0.f, Q = 0.f;
#pragma unroll
            for (int t = 0; t < 8; ++t) { const unsigned long long w = __hip_atomic_load(sp + t, __ATOMIC_RELAXED, __HIP_MEMORY_SCOPE_AGENT); S += __uint_as_float((unsigned)w); Q += __uint_as_float((unsigned)(w >> 32)); }
            const float mean = S * (1.0f / DM), var = Q * (1.0f / DM) - mean * mean;
            ST[tid] = (f32x2v){mean, rsqrtf(fmaxf(var, 0.f) + 1e-5f)};
        }
        __syncthreads();
#pragma unroll
        for (int bj = 0; bj < 2; ++bj)
#pragma unroll
            for (int n = 0; n < 2; ++n) {
                const f32x4 gg = *(const f32x4*)(g + col0 + bj * 128 + n * 16), bb = *(const f32x4*)(b + col0 + bj * 128 + n * 16);
#pragma unroll
                for (int ai = 0; ai < 2; ++ai)
#pragma unroll
                    for (int m = 0; m < 4; ++m) {
                        const f32x2v sr = ST[ai * 128 + wr * 64 + m * 16 + fr];
                        const size_t off = (size_t)(row0 + ai * 128 + m * 16) * DM + col0 + bj * 128 + n * 16;
                        const f32x4 o = (acc[ai][bj][m][n] - sr.x) * sr.y * gg + bb;
                        if (out32) *(f32x4*)(out32 + off) = o;
                        else { *(h16x4*)(xh + off) = __builtin_convertvector(o, h16x4);
                               u32x2 w; w.x = pk2(o[0], o[1]); w.y = pk2(o[2], o[3]); *(u32x2*)(xb + off) = w; }
                    }
            }
    }
};

struct EpiMlaDown {
    static constexpr bool PERM = true, AFTER_DRAIN = false;
    bf16_t* cq; bf16_t* ckv; float* kr32; float* part;
    __device__ __forceinline__ void operator()(const pg8::f32x4 (&acc)[2][2][4][2], const pg8::Unit& u, int wr, int wc, int fr, int fq) const {
        const int row0 = u.pm * 256 + wr * 64 + fr;
        if (u.pn < 4) {
            bf16_t* dst = (u.pn < 2 ? cq : ckv) + (u.pn & 1) * 256 + wc * 32 + 8 * fq;
#pragma unroll
            for (int ai = 0; ai < 2; ++ai)
#pragma unroll
                for (int m = 0; m < 4; ++m) { const int row = row0 + ai * 128 + m * 16; float q = 0.f;
#pragma unroll
                    for (int bj = 0; bj < 2; ++bj) { const f32x4 v0 = acc[ai][bj][m][0], v1 = acc[ai][bj][m][1];
                        q += (v0[0] * v0[0] + v0[1] * v0[1]) + (v0[2] * v0[2] + v0[3] * v0[3]) + (v1[0] * v1[0] + v1[1] * v1[1]) + (v1[2] * v1[2] + v1[3] * v1[3]);
                        u32x4 w; w.x = pk2(v0[0], v0[1]); w.y = pk2(v0[2], v0[3]); w.z = pk2(v1[0], v1[1]); w.w = pk2(v1[2], v1[3]);
                        *(u32x4*)(dst + (size_t)row * 512 + bj * 128) = w; }
                    q = rsum32(rsum16(q));
                    if (fq == 0) part[(size_t)row * 16 + u.pn * 4 + wc] = q; }
        } else if (wc < 2) {
#pragma unroll
            for (int ai = 0; ai < 2; ++ai)
#pragma unroll
                for (int m = 0; m < 4; ++m) { float* rp = kr32 + (size_t)(row0 + ai * 128 + m * 16) * 64 + wc * 32 + 8 * fq;
                    *(f32x4*)rp = acc[ai][0][m][0]; *(f32x4*)(rp + 4) = acc[ai][0][m][1]; }
        }
    }
};
struct EpiBf16RowScale {
    static constexpr bool PERM = true, AFTER_DRAIN = false;
    bf16_t* O; int ldc; const float* part; int sel;
    __device__ __forceinline__ void operator()(const pg8::f32x4 (&acc)[2][2][4][2], const pg8::Unit& u, int wr, int wc, int fr, int fq) const {
        const int row0 = u.pm * 256 + wr * 64 + fr; const int col0 = u.pn * 256 + wc * 32 + 8 * fq;
#pragma unroll
        for (int ai = 0; ai < 2; ++ai)
#pragma unroll
            for (int m = 0; m < 4; ++m) { const int row = row0 + ai * 128 + m * 16;
                const f32x4 a = *(const f32x4*)(part + (size_t)row * 16 + sel * 8), b = *(const f32x4*)(part + (size_t)row * 16 + sel * 8 + 4);
                const float r = rsqrtf((((a[0] + a[1]) + (a[2] + a[3])) + ((b[0] + b[1]) + (b[2] + b[3]))) * (1.0f / 512.0f) + 1e-6f);
                bf16_t* rowp = O + (size_t)row * ldc + col0;
#pragma unroll
                for (int bj = 0; bj < 2; ++bj) { const f32x4 v0 = acc[ai][bj][m][0] * r, v1 = acc[ai][bj][m][1] * r;
                    u32x4 w; w.x = pk2(v0[0], v0[1]); w.y = pk2(v0[2], v0[3]); w.z = pk2(v1[0], v1[1]); w.w = pk2(v1[2], v1[3]);
                    *(u32x4*)(rowp + bj * 128) = w; } }
    }
};
__device__ __forceinline__ void mla_krope_step(const Params& p) {
    const int tid = ltid();
    for (int i = blockIdx.x * 512 + tid; i < NTOK * 32; i += gridDim.x * 512) {
        const int row = i >> 5, f = i & 31, s = row % SEQ;
        const float t1 = p.kr32[(size_t)row * 64 + f], t2 = p.kr32[(size_t)row * 64 + 32 + f];
        const float c = p.rope[s * 64 + f], sn = p.rope[s * 64 + 32 + f];
        p.krope[(size_t)row * 64 + f] = f2bf(t1 * c - t2 * sn); p.krope[(size_t)row * 64 + 32 + f] = f2bf(t1 * sn + t2 * c);
    }
}

template <class Epi>
__device__ __forceinline__ void run_gemm(LAS unsigned char* lds, const bf16_t* A, const bf16_t* Bt, int N, int K, const Epi& E) {
    pg8::Gemm g{A, Bt, NTOK, N, K}; pg8::StaticOrder S; S.init(NTOK, N, (int)gridDim.x, (int)blockIdx.x);
    pg8::gemm_phase<Epi, pg8::StaticOrder, false>(lds, g, S, E, nullptr);
    __syncthreads();
}

__global__ void __launch_bounds__(512) mega(Params p_unused) {
    extern __shared__ __attribute__((aligned(16))) unsigned char lds_raw[];
    LAS unsigned char* lds = (LAS unsigned char*)lds_raw;
    cg::grid_group grid = cg::this_grid();
    KP kp = (KP)__builtin_amdgcn_kernarg_segment_ptr();
    volatile LAS unsigned* stw = (volatile LAS unsigned*)(lds + 131072);
    {
        const Params& p = PK(kp);
        if (blockIdx.x == 0) for (int i = ltid(); i < XCD_BAR_WORDS; i += 512) p.bar[i] = 0u;
        if (blockIdx.x == 1) for (int i = ltid(); i < 32 * 64 + 64; i += 512) p.pcnt[i] = 0u;
        if (ltid() < 4) stw[ltid()] = 0u;
    }
    phase0(PK(kp), lds);
    grid.sync();
    XcdBarrier xbar = xcd_barrier_post(PK(kp).bar, stw);
#pragma unroll 1
    for (int L = 0; L < 4; ++L) {
        {
            const Params& p = PK(kp);
            const bf16_t* win = (L == 0) ? p.w_moba_qkv : (L == 1) ? p.w_swa_qkv : p.w_nsa_in;
            const int nin = (L == 0) ? MOBA_LD : (L == 1) ? SWA_LD : NSA_LD;
            if (L != 3) run_gemm(lds, p.xb, win, nin, DM, pg8::EpiBf16{p.proj, nin});
            else run_gemm(lds, p.xb, p.w_mla_down, MLA_DN_LD, DM, EpiMlaDown{p.cqn, p.ckvn, p.kr32, p.part});
        }
        xcd_barrier(xbar);
        if (L == 0) {
            moba_kmean_phase(PK(kp), lds);
            xcd_barrier(xbar);
            moba_attn_phase(PK(kp), lds);
        } else if (L == 1) {
            swa_attn_phase(PK(kp), lds);
        } else if (L == 2) {
            nsa_cmp1_phase(PK(kp), lds);
            xcd_barrier(xbar);
            nsa_cmp2_phase(PK(kp));
            xcd_barrier(xbar);
            nsa_attn_phase(PK(kp), lds);
        } else {
            mla_krope_step(PK(kp));
#pragma unroll 1
            for (int i = 0; i < 2; ++i) {
                const Params& p = PK(kp);
                run_gemm(lds, i ? p.ckvn : p.cqn, i ? p.w_mla_ukv : p.w_mla_uq, i ? MLA_KV_LD : MLA_Q_LD, 512,
                         EpiBf16RowScale{p.proj + (i ? (size_t)NTOK * MLA_Q_LD : 0), i ? MLA_KV_LD : MLA_Q_LD, p.part, i});
            }
            xcd_barrier(xbar);
            mla_attn_phase(PK(kp), lds);
        }
        xcd_barrier(xbar);
        {
            const Params& p = PK(kp);
            const bf16_t* wo = (L == 0) ? p.w_moba_o : (L == 1) ? p.w_swa_o : (L == 2) ? p.w_nsa_o : p.w_mla_o;
            if (L == 0) run_gemm(lds, p.att, wo, DM, DM, EpiResLN{p.x, nullptr, ALPHA_F, p.ln1_g, p.ln1_b, nullptr, p.xh, p.xb, p.stats, p.pcnt, 8u, p.pcnt + 32 * 64});
            else run_gemm(lds, p.att, wo, DM, DM, EpiResLN{nullptr, p.xh, ALPHA_F, p.ln1_g + L * DM, p.ln1_b + L * DM, nullptr, p.xh, p.xb, p.stats, p.pcnt, 8u * (unsigned)(2 * L + 1), p.pcnt + 32 * 64});
        }
        xcd_barrier(xbar);
        { const Params& p = PK(kp); run_gemm(lds, p.xb, p.w_gu + (size_t)L * 2 * DFF * DM, 2 * DFF, DM, pg8::EpiSwiGLU{p.hid, DFF}); }
        xcd_barrier(xbar);
        { const Params& p = PK(kp); run_gemm(lds, p.hid, p.w_dn + (size_t)L * DM * DFF, DM, DFF,
                                             EpiResLN{nullptr, p.xh, ALPHA_F, p.ln2_g + L * DM, p.ln2_b + L * DM, (L == 3) ? p.out : nullptr, p.xh, p.xb, p.stats, p.pcnt, 8u * (unsigned)(2 * L + 2), p.pcnt + 32 * 64}); }
        if (L < 3) xcd_barrier(xbar);
    }
}

extern "C" void kernel_launch(void* const* d_in, const int* in_sizes, int n_in, void* d_out, int out_size, void* d_ws, size_t ws_size, hipStream_t stream) {
    (void)in_sizes; (void)n_in; (void)out_size;
    static int grid_blocks = 0;
    if (!grid_blocks) {
        int dev = 0, cus = 0, per_cu = 0;
        hipGetDevice(&dev);
        hipDeviceGetAttribute(&cus, hipDeviceAttributeMultiprocessorCount, dev);
        hipFuncSetAttribute((const void*)mega, hipFuncAttributeMaxDynamicSharedMemorySize, LDS_BYTES);
        hipOccupancyMaxActiveBlocksPerMultiprocessor(&per_cu, (const void*)mega, 512, LDS_BYTES);
        if (per_cu < 1) per_cu = 1;
        grid_blocks = cus * 1;
        (void)hipGetLastError();
    }
    const float* const* in = (const float* const*)d_in;
    Params p{};
    p.x = in[0]; p.rel_bias = in[1]; p.swa_sinks = in[5]; p.cmp_pos = in[8]; p.cmp_w1 = in[9];
    p.q_norm = in[13]; p.kv_norm = in[14];
    p.ln1_g = in[18]; p.ln1_b = in[19]; p.ln2_g = in[23]; p.ln2_b = in[24];
    p.out = (float*)d_out;
    unsigned char* ws = (unsigned char*)d_ws; size_t off = 0;
    auto take = [&](size_t bytes) { unsigned char* r = ws + off; off += (bytes + 255) & ~(size_t)255; return r; };
    int nj = 0, tiles = 0;
    auto job = [&](const float* src, int K, int N, int Npad, int blk, int stride, int offr, bf16_t* dst) {
        CvtJob& j = p.jobs[nj++]; j.src = src; j.dst = dst; j.K = K; j.N = N; j.Npad = Npad; j.blk = blk; j.stride = stride; j.off = offr; j.tile0 = tiles; j.pad = 0; j.kscale = nullptr;
        tiles += ((K + 511) / 512) * (Npad / 64);
    };
    auto plain = [&](const float* src, int K, int N, int Npad) { bf16_t* d = (bf16_t*)take((size_t)Npad * K * 2); job(src, K, N, Npad, Npad, Npad, 0, d); return (const bf16_t*)d; };
    p.w_moba_qkv = plain(in[2], DM, 6144, 6144);
    p.w_moba_o = plain(in[3], DM, DM, DM);
    p.w_swa_qkv = plain(in[4], DM, 2560, 2560);
    p.w_swa_o = plain(in[6], DM, DM, DM);
    p.w_nsa_in = plain(in[7], DM, 5168, NSA_LD);
    p.w_nsa_o = plain(in[11], DM, DM, DM);
    { bf16_t* d = (bf16_t*)take((size_t)2 * 256 * 4096 * 2); p.w_cmp1 = d;
      for (int kv = 0; kv < 2; ++kv) job(in[9] + (size_t)kv * 4096 * 256, 4096, 256, 256, 256, 256, 0, d + (size_t)kv * 256 * 4096); }
    { bf16_t* d = (bf16_t*)take((size_t)2 * 128 * 256 * 2); p.w_cmp2 = d;
      for (int kv = 0; kv < 2; ++kv) job(in[10] + (size_t)kv * 256 * 128, 256, 128, 128, 128, 128, 0, d + (size_t)kv * 128 * 256); }
    p.w_mla_down = plain(in[12], DM, 1088, MLA_DN_LD);
    p.w_mla_uq = plain(in[15], 512, 3072, 3072); p.jobs[nj - 1].kscale = in[13];
    p.w_mla_ukv = plain(in[16], 512, 4096, 4096); p.jobs[nj - 1].kscale = in[14];
    p.w_mla_o = plain(in[17], DM, DM, DM);
    { bf16_t* d = (bf16_t*)take((size_t)4 * 2 * DFF * DM * 2); p.w_gu = d;
      for (int L = 0; L < 4; ++L) { job(in[20] + (size_t)L * DM * DFF, DM, DFF, DFF, 128, 256, 0, d + (size_t)L * 2 * DFF * DM); job(in[21] + (size_t)L * DM * DFF, DM, DFF, DFF, 128, 256, 128, d + (size_t)L * 2 * DFF * DM); } }
    { bf16_t* d = (bf16_t*)take((size_t)4 * DM * DFF * 2); p.w_dn = d;
      for (int L = 0; L < 4; ++L) job(in[22] + (size_t)L * DFF * DM, DFF, DM, DM, DM, DM, 0, d + (size_t)L * DM * DFF); }
    p.njobs = nj; p.total_tiles = tiles;
    p.xb = (bf16_t*)take((size_t)NTOK * DM * 2);
    p.xh = (_Float16*)take((size_t)NTOK * DM * 2);
    p.y = (float*)take((size_t)NTOK * DM * 4);
    p.cdown = p.y; p.kr32 = p.y; p.part = p.y + (size_t)NTOK * 64;
    p.proj = (bf16_t*)take((size_t)NTOK * 7168 * 2);
    p.hid = p.proj;
    p.att = (bf16_t*)take((size_t)NTOK * DM * 2);
    p.cqn = p.att; p.ckvn = p.att + (size_t)NTOK * 512;
    p.kmean = (float*)take((size_t)NB * NHEAD * 8 * 128 * 4);
    p.pe_b16 = (bf16_t*)take(2 * 4096 * 2);
    p.rope = (float*)take((size_t)SEQ * 64 * 4);
    p.cmp_hid = (bf16_t*)take((size_t)32 * 128 * 256 * 2);
    p.kcvc = (bf16_t*)take((size_t)32 * 128 * 128 * 2);
    p.krope = (bf16_t*)take((size_t)NTOK * 64 * 2);
    p.bar = (unsigned*)take((size_t)XCD_BAR_WORDS * 4);
    p.stats = (unsigned long long*)take((size_t)NTOK * 8 * 8);
    p.pcnt = (unsigned*)take((size_t)(32 * 64 + 64) * 4);
    if (off > ws_size || nj > NJOBS) { fprintf(stderr, "kernel_launch: workspace too small (%zu > %zu) or jobs %d\n", off, ws_size, nj); return; }
    void* args[] = {&p};
    hipError_t e = hipLaunchCooperativeKernel((const void*)mega, dim3(grid_blocks), dim3(512), args, LDS_BYTES, stream);
    if (e != hipSuccess) fprintf(stderr, "cooperative launch failed: %s (grid %d)\n", hipGetErrorString(e), grid_blocks);
}
```
